# Optimizing an MI355X kernel written in HIP

```python
import math
import jax, jax.numpy as jnp
from jax import lax
import numpy as np

D_MODEL = 1024
BATCH = 4
SEQ = 8192
DEPTH = 2

N_MIXERS = 2
N_CONV = (DEPTH + 1) // 2
N_ATTN = DEPTH // 2
CONV_WIDTH = 31
N_HEADS = 8
HEAD_DIM = D_MODEL // (2 * N_HEADS)
V_DIM = 2 * HEAD_DIM
Q_BLOCK = 128
NUM_BUCKETS = 32
MAX_EXACT = NUM_BUCKETS // 2
MAX_DISTANCE = 128
D_FF = int(math.ceil(8 * D_MODEL / 3 / 256) * 256)
PLE_DIM = 256
EPS = 1e-6

kernel_name = "hybrid_conformer_diffattn_trunk"


def rms_norm(x, g):
    xf = x.astype(jnp.float32)
    y = xf * lax.rsqrt(jnp.mean(xf * xf, axis=-1, keepdims=True) + EPS)
    return (y * g.astype(jnp.float32)).astype(x.dtype)


def layer_norm(x, g, b):
    xf = x.astype(jnp.float32)
    mu = jnp.mean(xf, axis=-1, keepdims=True)
    xc = xf - mu
    var = jnp.mean(xc * xc, axis=-1, keepdims=True)
    y = xc * lax.rsqrt(var + EPS) * g.astype(jnp.float32) + b.astype(jnp.float32)
    return y.astype(x.dtype)


def conformer_conv(x, w_pw1, b_pw1, dw_w, dw_b, ln_g, ln_b, w_pw2, b_pw2):
    a = x @ w_pw1 + b_pw1
    u = a[..., :D_MODEL] * jax.nn.sigmoid(a[..., D_MODEL:])
    u = lax.conv_general_dilated(
        u, dw_w[:, None, :].astype(u.dtype), window_strides=(1,),
        padding=[(CONV_WIDTH - 1, 0)],
        dimension_numbers=("NWC", "WIO", "NWC"),
        feature_group_count=D_MODEL) + dw_b
    u = jax.nn.silu(layer_norm(u, ln_g, ln_b))
    return u @ w_pw2 + b_pw2


def t5_bucket(dist):
    n = jnp.maximum(dist, 0)
    is_small = n < MAX_EXACT
    nf = jnp.maximum(n, 1).astype(jnp.float32)
    large = MAX_EXACT + (jnp.log(nf / MAX_EXACT) / math.log(MAX_DISTANCE / MAX_EXACT)
                         * (NUM_BUCKETS - MAX_EXACT)).astype(jnp.int32)
    large = jnp.minimum(large, NUM_BUCKETS - 1)
    return jnp.where(is_small, n, large)


def diff_attention(x, w_qkv, q_g, k_g, lq1, lk1, lq2, lk2, sub_g, w_o, rel_bias, lambda_init):
    B, S, _ = x.shape
    qkv = x @ w_qkv
    q, k, v = jnp.split(qkv, 3, axis=-1)
    q = rms_norm(q.reshape(B, S, N_HEADS, 2, HEAD_DIM), q_g) * (HEAD_DIM ** -0.5)
    k = rms_norm(k.reshape(B, S, N_HEADS, 2, HEAD_DIM), k_g)
    v = v.reshape(B, S, N_HEADS, V_DIM)
    q = jnp.transpose(q, (0, 2, 3, 1, 4))
    k = jnp.transpose(k, (0, 2, 3, 1, 4))
    v = jnp.transpose(v, (0, 2, 1, 3))
    lam = (jnp.exp(jnp.sum(lq1.astype(jnp.float32) * lk1.astype(jnp.float32)))
           - jnp.exp(jnp.sum(lq2.astype(jnp.float32) * lk2.astype(jnp.float32)))
           + lambda_init)
    n_blk = S // Q_BLOCK
    qb = jnp.moveaxis(q.reshape(B, N_HEADS, 2, n_blk, Q_BLOCK, HEAD_DIM), 3, 0)
    k_pos = jnp.arange(S, dtype=jnp.int32)

    def block(args):
        q_blk, bi = args
        q_pos = bi * Q_BLOCK + jnp.arange(Q_BLOCK, dtype=jnp.int32)
        dist = q_pos[:, None] - k_pos[None, :]
        bias = jnp.transpose(rel_bias[t5_bucket(dist)], (2, 0, 1)).astype(jnp.float32)
        logits = jnp.einsum('bhcqd,bhckd->bhcqk', q_blk, k).astype(jnp.float32)
        logits = logits + bias[None, :, None]
        logits = jnp.where(dist >= 0, logits, -jnp.inf)
        probs = jax.nn.softmax(logits, axis=-1)
        w = probs[:, :, 0] - lam * probs[:, :, 1]
        return jnp.einsum('bhqk,bhkd->bhqd', w.astype(v.dtype), v)

    outs = lax.map(block, (qb, jnp.arange(n_blk, dtype=jnp.int32)))
    o = jnp.transpose(outs, (1, 0, 3, 2, 4)).reshape(B, S, N_HEADS, V_DIM)
    o = rms_norm(o, sub_g) * (1.0 - lambda_init)
    return o.reshape(B, S, N_HEADS * V_DIM) @ w_o


def swiglu(x, w_gate, w_up, w_down):
    return (jax.nn.silu(x @ w_gate) * (x @ w_up)) @ w_down


def setup_inputs(seed: int = 0) -> dict:
    key = jax.random.key(seed)
    ks = iter(jax.random.split(key, 64))
    f32 = jnp.float32

    def nrm(shape, scale):
        return jax.random.normal(next(ks), shape, f32) * scale

    def gain(shape):
        return 1.0 + nrm(shape, 0.05)

    D = D_MODEL
    return {
        "x": nrm((BATCH, SEQ, D), 1.0),
        "p": nrm((DEPTH, BATCH, SEQ, PLE_DIM), 1.0),
        "conv_norm_g": gain((N_CONV, D)),
        "conv_w_pw1": nrm((N_CONV, D, 2 * D), D ** -0.5),
        "conv_b_pw1": nrm((N_CONV, 2 * D), 0.02),
        "conv_dw_w": nrm((N_CONV, CONV_WIDTH, D), CONV_WIDTH ** -0.5),
        "conv_dw_b": nrm((N_CONV, D), 0.02),
        "conv_ln_g": gain((N_CONV, D)),
        "conv_ln_b": nrm((N_CONV, D), 0.02),
        "conv_w_pw2": nrm((N_CONV, D, D), D ** -0.5),
        "conv_b_pw2": nrm((N_CONV, D), 0.02),
        "attn_norm_g": gain((N_ATTN, D)),
        "attn_w_qkv": nrm((N_ATTN, D, 3 * D), D ** -0.5),
        "attn_q_norm_g": gain((N_ATTN, HEAD_DIM)),
        "attn_k_norm_g": gain((N_ATTN, HEAD_DIM)),
        "attn_lambda_q1": nrm((N_ATTN, HEAD_DIM), 0.1),
        "attn_lambda_k1": nrm((N_ATTN, HEAD_DIM), 0.1),
        "attn_lambda_q2": nrm((N_ATTN, HEAD_DIM), 0.1),
        "attn_lambda_k2": nrm((N_ATTN, HEAD_DIM), 0.1),
        "attn_sub_norm_g": gain((N_ATTN, V_DIM)),
        "attn_w_o": nrm((N_ATTN, D, D), D ** -0.5),
        "rel_bias": nrm((NUM_BUCKETS, N_HEADS), 0.5),
        "ffn_norm_g": gain((DEPTH, D)),
        "ffn_w_gate": nrm((DEPTH, D, D_FF), D ** -0.5),
        "ffn_w_up": nrm((DEPTH, D, D_FF), D ** -0.5),
        "ffn_w_down": nrm((DEPTH, D_FF, D), D_FF ** -0.5),
        "ple_norm_g": gain((DEPTH, D)),
        "ple_w_gate": nrm((DEPTH, D, D), D ** -0.5),
        "ple_w_proj": nrm((DEPTH, PLE_DIM, D), PLE_DIM ** -0.5),
    }


def reference(x, p, conv_norm_g, conv_w_pw1, conv_b_pw1, conv_dw_w, conv_dw_b, conv_ln_g,
              conv_ln_b, conv_w_pw2, conv_b_pw2, attn_norm_g, attn_w_qkv, attn_q_norm_g,
              attn_k_norm_g, attn_lambda_q1, attn_lambda_k1, attn_lambda_q2, attn_lambda_k2,
              attn_sub_norm_g, attn_w_o, rel_bias, ffn_norm_g, ffn_w_gate, ffn_w_up, ffn_w_down,
              ple_norm_g, ple_w_gate, ple_w_proj):
    h = x
    for i in range(DEPTH):
        j = i // N_MIXERS
        if i % N_MIXERS == 0:
            u = rms_norm(h, conv_norm_g[j])
            h = h + conformer_conv(u, conv_w_pw1[j], conv_b_pw1[j], conv_dw_w[j], conv_dw_b[j],
                                   conv_ln_g[j], conv_ln_b[j], conv_w_pw2[j], conv_b_pw2[j])
        else:
            lambda_init = 0.8 - 0.6 * math.exp(-0.3 * i)
            u = rms_norm(h, attn_norm_g[j])
            h = h + diff_attention(u, attn_w_qkv[j], attn_q_norm_g[j], attn_k_norm_g[j],
                                   attn_lambda_q1[j], attn_lambda_k1[j], attn_lambda_q2[j],
                                   attn_lambda_k2[j], attn_sub_norm_g[j], attn_w_o[j],
                                   rel_bias, lambda_init)
        u = rms_norm(h, ffn_norm_g[i])
        h = h + swiglu(u, ffn_w_gate[i], ffn_w_up[i], ffn_w_down[i])
        gate = jax.nn.sigmoid(rms_norm(h, ple_norm_g[i]) @ ple_w_gate[i])
        h = h + gate * (p[i] @ ple_w_proj[i])
    return h
```

```cpp
#include <hip/hip_runtime.h>
#include <hip/hip_cooperative_groups.h>
#include <cstdio>
#include <cstdint>
namespace pg8 {
#define PG8_LAS __attribute__((address_space(3)))
typedef unsigned short bf16_t;
typedef short bf16x8 __attribute__((ext_vector_type(8)));
typedef float f32x4 __attribute__((ext_vector_type(4)));
typedef unsigned u32x4 __attribute__((ext_vector_type(4)));
constexpr int BM = 256, BK = 64, HALF = 128, HTB = HALF * BK * 2  , STAGE_BYTES = 8 * HTB, NXCD = 8, WGM = 8;

__host__ __device__ __forceinline__ int lds_byte(int r, int c) { const int st = (r >> 4) * 2 + (c >> 5), rr = r & 15, cc = c & 31, ob = rr * 64 + cc * 2; return st * 1024 + (ob ^ (((ob >> 9) & 1) << 5)); }
__host__ __device__ __forceinline__ void stage_rc(int b, int& R, int& C) { const int st = b / 1024, sb = b % 1024, swz = sb ^ (((sb >> 9) & 1) << 5); R = (st >> 1) * 16 + swz / 64; C = (st & 1) * 32 + (swz % 64) / 2; }
__host__ __device__ __forceinline__ int perm32(int rho) { const int n = rho >> 4, i = rho & 15; return 8 * (i >> 2) + 4 * n + (i & 3); }

__host__ __device__ __forceinline__ size_t tiled_off(int row, int col, int K) { return ((size_t)(row >> 7) * (K >> 6) + (col >> 6)) * 8192 + (lds_byte(row & 127, col & 63) >> 1); }
struct Unit { int pm, pn; };
struct Gemm { const bf16_t* A; const bf16_t* Bt; int M, N, K; };

struct StaticOrder {
    int nM, nN, nwg, G, c;
    __host__ __device__ void init(int M, int N, int G_, int c_) { nM = M / BM; nN = N / BM; nwg = nM * nN; G = G_; c = c_; }
    __host__ __device__ bool next(int i, Unit& u) const {
        const long L = (long)i * G + c; if (L >= nwg) return false;
        int wgid = (int)L; { const int q = nwg / NXCD, r = nwg % NXCD, xcd = wgid % NXCD, off = wgid / NXCD; wgid = (xcd < r ? xcd * (q + 1) : r * (q + 1) + (xcd - r) * q) + off; }
        const int nig = WGM * nN, gid = wgid / nig, fm = gid * WGM, gsz = (nM - fm) < WGM ? (nM - fm) : WGM;
        u.pm = fm + ((wgid % nig) % gsz); u.pn = (wgid % nig) / gsz; return true;
    }
    __device__ __forceinline__ void a_ready(const Unit&) const {}
    __device__ __forceinline__ void done(const Unit&) const {}
};

__device__ __forceinline__ unsigned cvt_pk_bf16(float lo, float hi) { unsigned r; asm volatile("v_cvt_pk_bf16_f32 %0, %1, %2" : "=v"(r) : "v"(lo), "v"(hi)); return r; }
typedef float f32x2 __attribute__((ext_vector_type(2)));
__device__ __forceinline__ float fast_sigmoid(float x) { return __builtin_amdgcn_rcpf(1.0f + __builtin_amdgcn_exp2f(x * -1.4426950408889634f)); }
__device__ __forceinline__ void load_rstd(const PG8_LAS float* rtab, int wr, int fr, float (&rs)[2][4]) {
#pragma unroll
    for (int ai = 0; ai < 2; ++ai)
#pragma unroll
        for (int m = 0; m < 4; ++m) rs[ai][m] = rtab[ai * HALF + wr * 64 + m * 16 + fr];
}
template <int MODE> struct EpiGated {
    static constexpr bool PERM = true, AFTER_DRAIN = false, RSTD = true;
    bf16_t* O; int ldc; const float* SS; const float* b0; const float* b1;
    __device__ __forceinline__ const float* rstd_src() const { return SS; }
    __device__ __forceinline__ void operator()(const f32x4 (&acc)[2][2][4][2], const Unit& u, int wr, int wc, int fr, int fq, const PG8_LAS float* rtab) const {
        const int row0 = u.pm * BM + wr * 64 + fr, lcol = u.pn * HALF + wc * 32 + 8 * fq;
        float rs[2][4]; load_rstd(rtab, wr, fr, rs);
        f32x4 bv[2], bg[2];
#pragma unroll
        for (int n = 0; n < 2; ++n) { bv[n] = (MODE == 0) ? *(const f32x4*)(b0 + lcol + 4 * n) : (f32x4){0.f, 0.f, 0.f, 0.f}; bg[n] = (MODE == 0) ? *(const f32x4*)(b1 + lcol + 4 * n) : (f32x4){0.f, 0.f, 0.f, 0.f}; }
#pragma unroll
        for (int ai = 0; ai < 2; ++ai)
#pragma unroll
            for (int m = 0; m < 4; ++m) { const float r = rs[ai][m]; float o[8];
#pragma unroll
                for (int n = 0; n < 2; ++n) { const f32x4 a = acc[ai][0][m][n] * r + bv[n], g = acc[ai][1][m][n] * r + bg[n];
#pragma unroll
                    for (int e = 0; e < 4; ++e) o[4 * n + e] = (MODE == 0) ? a[e] * fast_sigmoid(g[e]) : a[e] * fast_sigmoid(a[e]) * g[e]; }
                u32x4 w; w.x = cvt_pk_bf16(o[0], o[1]); w.y = cvt_pk_bf16(o[2], o[3]); w.z = cvt_pk_bf16(o[4], o[5]); w.w = cvt_pk_bf16(o[6], o[7]);
                if (MODE == 1) *(u32x4*)(O + tiled_off(row0 + ai * HALF + m * 16, lcol, ldc)) = w;
                else *(u32x4*)(O + (size_t)(row0 + ai * HALF + m * 16) * ldc + lcol) = w; }
    }
};
template <int MODE, bool BASEF32, bool OUTF32> struct EpiRes {
    static constexpr bool PERM = true, AFTER_DRAIN = false, RSTD = (MODE == 1);
    __device__ __forceinline__ const float* rstd_src() const { return SSin; }
    const float* base; const bf16_t* baseh; float* out; bf16_t* hb; float* SSout; const float* bias; const float* SSin; const bf16_t* pp;
    struct Grp { f32x4 b[2][2]; u32x4 h[2]; u32x4 p[2]; };
    __device__ __forceinline__ void load_grp(Grp& g, int row, int col0) const {
#pragma unroll
        for (int bj = 0; bj < 2; ++bj) { const size_t off = (size_t)row * 1024 + col0 + bj * HALF;
            if (BASEF32) { g.b[bj][0] = *(const f32x4*)(base + off); g.b[bj][1] = *(const f32x4*)(base + off + 4); }
            else g.h[bj] = *(const u32x4*)(baseh + tiled_off(row, col0 + bj * HALF, 1024));
            if (MODE == 1) g.p[bj] = *(const u32x4*)(pp + tiled_off(row, col0 + bj * HALF, 1024)); }
    }
    __device__ __forceinline__ void operator()(const f32x4 (&acc)[2][2][4][2], const Unit& u, int wr, int wc, int fr, int fq, const PG8_LAS float* rtab) const {
        const int row0 = u.pm * BM + wr * 64 + fr, col0 = u.pn * BM + wc * 32 + 8 * fq;
        f32x4 bv[2][2];
#pragma unroll
        for (int bj = 0; bj < 2; ++bj)
#pragma unroll
            for (int n = 0; n < 2; ++n) bv[bj][n] = (MODE == 0 && bias) ? *(const f32x4*)(bias + col0 + bj * HALF + 4 * n) : (f32x4){0.f, 0.f, 0.f, 0.f};
        Grp cur, nxt; load_grp(cur, row0, col0);
#pragma unroll
        for (int gi = 0; gi < 8; ++gi) { const int ai = gi >> 2, m = gi & 3; const int row = row0 + ai * HALF + m * 16; float ssq = 0.f;
            if (gi < 7) load_grp(nxt, row0 + ((gi + 1) >> 2) * HALF + ((gi + 1) & 3) * 16, col0);
            float rsr = 0.f;
            if (MODE == 1) rsr = rtab[ai * HALF + wr * 64 + m * 16 + fr];
#pragma unroll
            for (int bj = 0; bj < 2; ++bj) { const size_t off = (size_t)row * 1024 + col0 + bj * HALF;
                f32x4 v0, v1;
                if (BASEF32) { v0 = cur.b[bj][0]; v1 = cur.b[bj][1]; }
                else { const u32x4 hw = cur.h[bj];
                    v0 = (f32x4){__uint_as_float(hw.x << 16), __uint_as_float(hw.x & 0xffff0000u), __uint_as_float(hw.y << 16), __uint_as_float(hw.y & 0xffff0000u)};
                    v1 = (f32x4){__uint_as_float(hw.z << 16), __uint_as_float(hw.z & 0xffff0000u), __uint_as_float(hw.w << 16), __uint_as_float(hw.w & 0xffff0000u)}; }
                if (MODE == 0) { v0 += acc[ai][bj][m][0] + bv[bj][0]; v1 += acc[ai][bj][m][1] + bv[bj][1]; }
                else { const u32x4 pw = cur.p[bj]; const f32x4 a0 = acc[ai][bj][m][0] * rsr, a1 = acc[ai][bj][m][1] * rsr;
                    v0[0] += fast_sigmoid(a0[0]) * __uint_as_float(pw.x << 16); v0[1] += fast_sigmoid(a0[1]) * __uint_as_float(pw.x & 0xffff0000u);
                    v0[2] += fast_sigmoid(a0[2]) * __uint_as_float(pw.y << 16); v0[3] += fast_sigmoid(a0[3]) * __uint_as_float(pw.y & 0xffff0000u);
                    v1[0] += fast_sigmoid(a1[0]) * __uint_as_float(pw.z << 16); v1[1] += fast_sigmoid(a1[1]) * __uint_as_float(pw.z & 0xffff0000u);
                    v1[2] += fast_sigmoid(a1[2]) * __uint_as_float(pw.w << 16); v1[3] += fast_sigmoid(a1[3]) * __uint_as_float(pw.w & 0xffff0000u); }
                if (OUTF32) { *(f32x4*)(out + off) = v0; *(f32x4*)(out + off + 4) = v1; }
                else { u32x4 w; w.x = cvt_pk_bf16(v0[0], v0[1]); w.y = cvt_pk_bf16(v0[2], v0[3]); w.z = cvt_pk_bf16(v1[0], v1[1]); w.w = cvt_pk_bf16(v1[2], v1[3]);
                    *(u32x4*)(hb + tiled_off(row, col0 + bj * HALF, 1024)) = w;
                    ssq += (v0[0] * v0[0] + v0[1] * v0[1]) + (v0[2] * v0[2] + v0[3] * v0[3]) + (v1[0] * v1[0] + v1[1] * v1[1]) + (v1[2] * v1[2] + v1[3] * v1[3]); } }
            if (!OUTF32) { ssq += __shfl_xor(ssq, 16); ssq += __shfl_xor(ssq, 32);
                if (fq == 0) SSout[(size_t)row * 16 + u.pn * 4 + wc] = ssq; }
            asm volatile("" ::: "memory");
            cur = nxt; }
    }
};
struct EpiQKV {
    static constexpr bool PERM = true, AFTER_DRAIN = false, RSTD = true;
    __device__ __forceinline__ const float* rstd_src() const { return SS; }
    bf16_t* Q; bf16_t* K; bf16_t* V; const float* SS; const float* qg; const float* kg; float c2;
    __device__ __forceinline__ void operator()(const f32x4 (&acc)[2][2][4][2], const Unit& u, int wr, int wc, int fr, int fq, const PG8_LAS float* rtab) const {
        const int row0 = u.pm * BM + wr * 64 + fr; const int sec = u.pn >> 2, pt = u.pn & 3;
        float rs[2][4]; load_rstd(rtab, wr, fr, rs);
        if (sec == 2) {
            const int col0 = pt * BM + wc * 32 + 8 * fq;
#pragma unroll
            for (int ai = 0; ai < 2; ++ai)
#pragma unroll
                for (int m = 0; m < 4; ++m) { const float r = rs[ai][m];
#pragma unroll
                    for (int bj = 0; bj < 2; ++bj) { const f32x4 v0 = acc[ai][bj][m][0] * r, v1 = acc[ai][bj][m][1] * r;
                        u32x4 w; w.x = cvt_pk_bf16(v0[0], v0[1]); w.y = cvt_pk_bf16(v0[2], v0[3]); w.z = cvt_pk_bf16(v1[0], v1[1]); w.w = cvt_pk_bf16(v1[2], v1[3]);
                        const int row = row0 + ai * HALF + m * 16, b_ = row >> 13, s_ = row & 8191, h_ = 2 * pt + bj;
                        *(u32x4*)(V + ((size_t)((b_ * 8 + h_) * 128 + (s_ >> 6))) * 8192 + wc * 2048 + (s_ & 63) * 32 + fq * 8) = w; } }
        } else {
            bf16_t* O = sec == 0 ? Q : K; const float* g = sec == 0 ? qg : kg; const float sc = sec == 0 ? c2 : 1.0f;
            f32x4 gv[2][2];
#pragma unroll
            for (int bj = 0; bj < 2; ++bj)
#pragma unroll
                for (int n = 0; n < 2; ++n) gv[bj][n] = *(const f32x4*)(g + 32 * bj + 8 * fq + 4 * n) * sc;
            const int lcol = 64 * (4 * pt + wc) + 8 * fq;
#pragma unroll
            for (int ai = 0; ai < 2; ++ai)
#pragma unroll
                for (int m = 0; m < 4; ++m) { const float r = rs[ai][m]; float ssq = 0.f;
#pragma unroll
                    for (int bj = 0; bj < 2; ++bj)
#pragma unroll
                        for (int n = 0; n < 2; ++n) { const f32x4 a = acc[ai][bj][m][n]; ssq += (a[0] * a[0] + a[1] * a[1]) + (a[2] * a[2] + a[3] * a[3]); }
                    ssq += __shfl_xor(ssq, 16); ssq += __shfl_xor(ssq, 32);
                    const float s = r * __builtin_amdgcn_rsqf(r * r * ssq * (1.0f / 64.0f) + 1e-6f);
#pragma unroll
                    for (int bj = 0; bj < 2; ++bj) { const f32x4 v0 = acc[ai][bj][m][0] * s * gv[bj][0], v1 = acc[ai][bj][m][1] * s * gv[bj][1];
                        u32x4 w; w.x = cvt_pk_bf16(v0[0], v0[1]); w.y = cvt_pk_bf16(v0[2], v0[3]); w.z = cvt_pk_bf16(v1[0], v1[1]); w.w = cvt_pk_bf16(v1[2], v1[3]);
                        const int row = row0 + ai * HALF + m * 16;
                        if (sec == 0) *(u32x4*)(O + (size_t)row * 1024 + lcol + 32 * bj) = w;
                        else { const int b_ = row >> 13, s_ = row & 8191; *(u32x4*)(O + ((size_t)((b_ * 16 + 4 * pt + wc) * 128 + (s_ >> 6))) * 4096 + (4 * bj + fq) * 512 + (s_ & 63) * 8) = w; } } }
        }
    }
};
struct EpiPlain {
    static constexpr bool PERM = true, AFTER_DRAIN = false, RSTD = false;
    __device__ __forceinline__ const float* rstd_src() const { return nullptr; }
    bf16_t* O; int ldc;
    __device__ __forceinline__ void operator()(const f32x4 (&acc)[2][2][4][2], const Unit& u, int wr, int wc, int fr, int fq, const PG8_LAS float* rtab) const {
        const int row0 = u.pm * BM + wr * 64 + fr, col0 = u.pn * BM + wc * 32 + 8 * fq;
#pragma unroll
        for (int ai = 0; ai < 2; ++ai)
#pragma unroll
            for (int m = 0; m < 4; ++m)
#pragma unroll
                for (int bj = 0; bj < 2; ++bj) { const f32x4 v0 = acc[ai][bj][m][0], v1 = acc[ai][bj][m][1];
                    u32x4 w; w.x = cvt_pk_bf16(v0[0], v0[1]); w.y = cvt_pk_bf16(v0[2], v0[3]); w.z = cvt_pk_bf16(v1[0], v1[1]); w.w = cvt_pk_bf16(v1[2], v1[3]);
                    *(u32x4*)(O + tiled_off(row0 + ai * HALF + m * 16, col0 + bj * HALF, ldc)) = w; }
    }
};
template <class Epi, class Sched, bool ALIGN_EPI = false, bool SP2 = false, bool TA = true>
__device__ __forceinline__ void gemm_phase(PG8_LAS unsigned char* lds, const Gemm g, const Sched& S, const Epi& E) {
    const int tid = threadIdx.x, wid = __builtin_amdgcn_readfirstlane(tid >> 6), lane = tid & 63, wr = wid >> 2, wc = wid & 3, fr = lane & 15, fq = lane >> 4;
    const int K = g.K, nt = K / BK;
    unsigned voffA[2], voffB[2];
#pragma unroll
    for (int i = 0; i < 2; ++i) { int R, C; stage_rc(tid * 16 + i * 8192, R, C); const int Rb = Epi::PERM ? ((R & ~31) + perm32(R & 31)) : R;
        voffA[i] = TA ? (unsigned)(tid * 16 + i * 8192) : (unsigned)(R * K + C) * 2u; voffB[i] = (unsigned)(tid * 16 + i * 8192); (void)Rb; }
    const size_t kstep = TA ? (size_t)HTB : (size_t)(BK * 2);
    const size_t kstepB = (size_t)HTB;
    const size_t hstep = (size_t)HALF * K * 2;
    const size_t tstep = 2 * hstep;
    const unsigned ldsw = (unsigned)wid * 1024u;
    const int aoff = lds_byte(wr * 64 + fr, fq * 8), boff = lds_byte(wc * 32 + fr, fq * 8);
#define PG8_SA(b, h) (((b) * 2 + (h)) * HTB)
#define PG8_SB(b, h) ((4 + (b) * 2 + (h)) * HTB)
#define PG8_STAGE(bufoff, gbase, voff) do { _Pragma("unroll") for (int _i = 0; _i < 2; ++_i) \
        __builtin_amdgcn_global_load_lds((const unsigned*)((const char*)(gbase) + (voff)[_i]), (PG8_LAS unsigned*)(lds + (bufoff) + ldsw + _i * 8192), 16, 0, 0); } while (0)
#define PG8_LDA(dst, b, h) do { _Pragma("unroll") for (int m = 0; m < 4; ++m) _Pragma("unroll") for (int k = 0; k < 2; ++k) dst[m][k] = *(const PG8_LAS bf16x8*)(lds + PG8_SA(b, h) + aoff + m * 2048 + k * 1024); } while (0)
#define PG8_LDB(dst, b, h) do { _Pragma("unroll") for (int n = 0; n < 2; ++n) _Pragma("unroll") for (int k = 0; k < 2; ++k) dst[n][k] = *(const PG8_LAS bf16x8*)(lds + PG8_SB(b, h) + boff + n * 2048 + k * 1024); } while (0)
#define PG8_MMA(ai, bj, At, Bt) do { __builtin_amdgcn_s_setprio(1); _Pragma("unroll") for (int m = 0; m < 4; ++m) _Pragma("unroll") for (int n = 0; n < 2; ++n) _Pragma("unroll") for (int k = 0; k < 2; ++k) \
        acc[ai][bj][m][n] = __builtin_amdgcn_mfma_f32_16x16x32_bf16(Bt[n][k], At[m][k], acc[ai][bj][m][n], 0, 0, 0); __builtin_amdgcn_s_setprio(0); } while (0)
#define PG8_WAIT_V(n) asm volatile("s_waitcnt vmcnt(" #n ")" ::: "memory")
#define PG8_WAIT_L(n) asm volatile("s_waitcnt lgkmcnt(" #n ")" ::: "memory")
#define PG8_BAR __builtin_amdgcn_s_barrier()
#define PG8_SCHED __builtin_amdgcn_sched_barrier(0)
    Unit cur, nxt; int ui = 0;
    if (!S.next(0, cur)) return;
#define PG8_RTAB(u_, ui_) do { if constexpr (Epi::RSTD) { if (tid < 256) { const f32x4* p_ = (const f32x4*)(E.rstd_src() + (size_t)((u_).pm * BM + tid) * 16); const f32x4 s4_ = (p_[0] + p_[1]) + (p_[2] + p_[3]); \
        ((PG8_LAS float*)(lds + STAGE_BYTES + 1024 + ((ui_) & 1) * 1024))[tid] = __builtin_amdgcn_rsqf(((s4_[0] + s4_[1]) + (s4_[2] + s4_[3])) * (1.0f / 1024.0f) + 1e-6f); } } } while (0)
    PG8_RTAB(cur, 0);
    f32x4 acc[2][2][4][2];
#pragma unroll
    for (int a = 0; a < 2; ++a)
#pragma unroll
        for (int b = 0; b < 2; ++b)
#pragma unroll
            for (int m = 0; m < 4; ++m)
#pragma unroll
                for (int n = 0; n < 2; ++n) acc[a][b][m][n] = (f32x4){0.f, 0.f, 0.f, 0.f};
    bf16x8 At[4][2], B0[2][2], B1[2][2];
    const char* cA = (const char*)g.A + (size_t)cur.pm * tstep; const char* cB = (const char*)g.Bt + (size_t)cur.pn * tstep;
    S.a_ready(cur);
    if constexpr (SP2) {
        PG8_STAGE(PG8_SB(0, 0), cB, voffB); PG8_STAGE(PG8_SB(0, 1), cB + hstep, voffB); PG8_STAGE(PG8_SA(0, 0), cA, voffA); PG8_STAGE(PG8_SA(0, 1), cA + hstep, voffA);
        if (wr == 1) PG8_BAR;
        PG8_WAIT_V(2); PG8_BAR;
        PG8_STAGE(PG8_SB(1, 0), cB + kstepB, voffB); PG8_STAGE(PG8_SA(1, 0), cA + kstep, voffA); PG8_STAGE(PG8_SB(1, 1), cB + hstep + kstepB, voffB);
        PG8_WAIT_V(6); PG8_BAR;
    } else {
        PG8_STAGE(PG8_SB(0, 0), cB, voffB); PG8_STAGE(PG8_SA(0, 0), cA, voffA); PG8_STAGE(PG8_SB(0, 1), cB + hstep, voffB); PG8_STAGE(PG8_SA(0, 1), cA + hstep, voffA);
        if (wr == 1) PG8_BAR;
        PG8_WAIT_V(4); PG8_BAR;
        PG8_STAGE(PG8_SB(1, 0), cB + kstepB, voffB); PG8_STAGE(PG8_SA(1, 0), cA + kstep, voffA); PG8_STAGE(PG8_SB(1, 1), cB + hstep + kstepB, voffB);
        PG8_WAIT_V(6); PG8_BAR;
    }
    for (;;) {
        const bool has_next = S.next(ui + 1, nxt);
        const char* nA = has_next ? (const char*)g.A + (size_t)nxt.pm * tstep : cA; const char* nB = has_next ? (const char*)g.Bt + (size_t)nxt.pn * tstep : cB;
#pragma unroll 1
        for (int t = 0; t < nt; t += 2) {
            const bool last = (t == nt - 2);
            const char* a1 = cA + (size_t)(t + 1) * kstep;
            const char* a2 = last ? nA : cA + (size_t)(t + 2) * kstep; const char* b2 = last ? nB : cB + (size_t)(t + 2) * kstepB;
            const char* a3 = a2 + kstep; const char* b3 = b2 + kstepB;
            if (last && has_next) S.a_ready(nxt);
            if constexpr (SP2) {
            PG8_LDB(B0, 0, 0); PG8_LDB(B1, 0, 1); PG8_SCHED; PG8_LDA(At, 0, 0); PG8_STAGE(PG8_SA(1, 1), a1 + hstep, voffA);
            PG8_WAIT_V(8); PG8_WAIT_L(0); PG8_BAR; PG8_MMA(0, 0, At, B0); PG8_MMA(0, 1, At, B1); PG8_BAR; PG8_SCHED;
            PG8_LDA(At, 0, 1); PG8_STAGE(PG8_SB(0, 0), b2, voffB); PG8_STAGE(PG8_SB(0, 1), b2 + hstep, voffB); PG8_STAGE(PG8_SA(0, 0), a2, voffA);
            PG8_WAIT_V(8); PG8_WAIT_L(0); PG8_BAR; PG8_MMA(1, 0, At, B0); PG8_MMA(1, 1, At, B1); PG8_BAR; PG8_SCHED;
            PG8_LDB(B0, 1, 0); PG8_LDB(B1, 1, 1); PG8_SCHED; PG8_LDA(At, 1, 0); PG8_STAGE(PG8_SA(0, 1), a2 + hstep, voffA);
            PG8_WAIT_V(8); PG8_WAIT_L(0); PG8_BAR; PG8_MMA(0, 0, At, B0); PG8_MMA(0, 1, At, B1); PG8_BAR; PG8_SCHED;
            PG8_LDA(At, 1, 1); PG8_STAGE(PG8_SB(1, 0), b3, voffB); PG8_STAGE(PG8_SB(1, 1), b3 + hstep, voffB); PG8_STAGE(PG8_SA(1, 0), a3, voffA);
            PG8_WAIT_V(8); PG8_WAIT_L(0); PG8_BAR; PG8_MMA(1, 0, At, B0); PG8_MMA(1, 1, At, B1); PG8_BAR; PG8_SCHED;
            } else {
            PG8_LDB(B0, 0, 0); PG8_SCHED; PG8_LDA(At, 0, 0); PG8_STAGE(PG8_SA(1, 1), a1 + hstep, voffA);
            PG8_WAIT_L(8); PG8_BAR; PG8_WAIT_L(0); PG8_MMA(0, 0, At, B0); PG8_BAR; PG8_SCHED;
            PG8_LDB(B1, 0, 1); PG8_STAGE(PG8_SB(0, 0), b2, voffB);
            PG8_BAR; PG8_WAIT_L(0); PG8_MMA(0, 1, At, B1); PG8_BAR;
            PG8_LDA(At, 0, 1); PG8_STAGE(PG8_SA(0, 0), a2, voffA);
            PG8_BAR; PG8_WAIT_L(0); PG8_MMA(1, 0, At, B0); PG8_BAR; PG8_SCHED;
            PG8_STAGE(PG8_SB(0, 1), b2 + hstep, voffB);
            PG8_WAIT_V(6); PG8_BAR; PG8_MMA(1, 1, At, B1); PG8_BAR;
            PG8_LDB(B0, 1, 0); PG8_SCHED; PG8_LDA(At, 1, 0); PG8_STAGE(PG8_SA(0, 1), a2 + hstep, voffA);
            PG8_WAIT_L(8); PG8_BAR; PG8_WAIT_L(0); PG8_MMA(0, 0, At, B0); PG8_BAR; PG8_SCHED;
            PG8_LDB(B1, 1, 1); PG8_STAGE(PG8_SB(1, 0), b3, voffB);
            PG8_BAR; PG8_WAIT_L(0); PG8_MMA(0, 1, At, B1); PG8_BAR;
            PG8_LDA(At, 1, 1); PG8_STAGE(PG8_SA(1, 0), a3, voffA);
            PG8_BAR; PG8_WAIT_L(0); PG8_MMA(1, 0, At, B0); PG8_BAR; PG8_SCHED;
            PG8_STAGE(PG8_SB(1, 1), b3 + hstep, voffB);
            PG8_WAIT_V(6); PG8_BAR; PG8_MMA(1, 1, At, B1); PG8_BAR;
            }
        }
        if constexpr (ALIGN_EPI) { if (wr == 0) PG8_BAR; }
        if constexpr (!Epi::AFTER_DRAIN) { E(acc, cur, wr, wc, fr, fq, (const PG8_LAS float*)(lds + STAGE_BYTES + 1024 + (ui & 1) * 1024)); S.done(cur); }
        if (!has_next) break;
#pragma unroll
        for (int a = 0; a < 2; ++a)
#pragma unroll
            for (int b = 0; b < 2; ++b)
#pragma unroll
                for (int m = 0; m < 4; ++m)
#pragma unroll
                    for (int n = 0; n < 2; ++n) acc[a][b][m][n] = (f32x4){0.f, 0.f, 0.f, 0.f};
        cur = nxt; cA = nA; cB = nB; ++ui;
        PG8_RTAB(cur, ui);
        if constexpr (ALIGN_EPI) { if (wr == 1) PG8_BAR; }
    }
    PG8_WAIT_V(0);
    if constexpr (!ALIGN_EPI) { if (wr == 0) PG8_BAR; }
    PG8_BAR;
    if constexpr (Epi::AFTER_DRAIN) { E.fused(acc, cur, wr, wc, fr, fq, lds, wid, lane); S.done(cur); }
#undef PG8_RTAB
#undef PG8_SA
#undef PG8_SB
#undef PG8_STAGE
#undef PG8_LDA
#undef PG8_LDB
#undef PG8_MMA
#undef PG8_WAIT_V
#undef PG8_WAIT_L
#undef PG8_BAR
#undef PG8_SCHED
}
}

#ifndef PG8_SP2
#define PG8_SP2 true
#endif
#ifndef PG8_ALIGN
#define PG8_ALIGN true
#endif
#include <hip/hip_bf16.h>
#include <cmath>
namespace attn_body {
using bf16=__hip_bfloat16;
using bf16x8=__attribute__((ext_vector_type(8)))short;
using s16x4=__attribute__((ext_vector_type(4)))short;
using f32x16=__attribute__((ext_vector_type(16)))float;
using u32x4=__attribute__((ext_vector_type(4)))unsigned;
constexpr int BATCH=4,NHEAD=16,SEQ=8192,D=64,DM=NHEAD*D;
constexpr int NW=8,QBLK=32,QB=QBLK*NW,KVBLK=64,NQB=SEQ/QB;
constexpr int ATTN_PITCH=DM, ATTN_UNIT_ROWS=QB;
__device__ __forceinline__ int crow(int r,int hi){return (r&3)+8*(r>>2)+4*hi;}
#define SBAR() __builtin_amdgcn_sched_barrier(0)
typedef __attribute__((address_space(3))) const float* lds_cfptr;
__device__ __forceinline__ void cmask(f32x16&p0,f32x16&p1,int jb,int qrel,int hi,lds_cfptr bt){
  const float NEG=-INFINITY; int kb=64*jb+4*hi;
  #pragma unroll
  for(int r=0;r<16;++r){int kv=kb+(r&3)+8*(r>>2); const int d0=qrel-kv,d1=d0-32;
    const float b0=bt[d0<0?0:(d0>127?127:d0)],b1=bt[d1<0?0:(d1>127?127:d1)];
    p0[r]=d0<0?NEG:p0[r]+b0; p1[r]=d1<0?NEG:p1[r]+b1;}
}

constexpr int NSLOT=3, SLOTB=8192;
constexpr int LDS_K=0, LDS_V=NSLOT*SLOTB, LDS_WS=3*NSLOT*SLOTB, LDS_OST=LDS_WS+NW*64*4, LDS_BIAS=LDS_OST+NW*4096, LDS_BYTES=LDS_BIAS+4096;
constexpr float C2=0.125f*1.4426950408889634f;
__device__ __forceinline__ void glds16(const void*gsrc,unsigned lds_dst){unsigned keep;
  asm volatile("s_mov_b32 %0, m0\n\ts_mov_b32 m0, %2\n\ts_nop 0\n\tglobal_load_lds_dwordx4 %1, off\n\ts_mov_b32 m0, %0":"=&s"(keep):"v"(gsrc),"s"(lds_dst):"memory");}
__device__ __forceinline__ float max3f(float a,float b,float c){float r;asm("v_max3_f32 %0, %1, %2, %3":"=v"(r):"v"(a),"v"(b),"v"(c));return r;}
__device__ __forceinline__ float max2f(float a,float b){float r;asm("v_max_f32_e32 %0, %1, %2":"=v"(r):"v"(a),"v"(b));return r;}
__device__ __forceinline__ float fadd_s(float a,float b){float r;asm("v_add_f32_e32 %0, %1, %2":"=v"(r):"v"(a),"v"(b));return r;}
__device__ __forceinline__ float fsub_s(float a,float b){float r;asm("v_sub_f32_e32 %0, %1, %2":"=v"(r):"v"(a),"v"(b));return r;}
typedef float f32x2_t __attribute__((ext_vector_type(2))); typedef __bf16 bf16x2_t __attribute__((ext_vector_type(2)));
__device__ __forceinline__ unsigned cvtpk_s(float lo,float hi){f32x2_t v={lo,hi};bf16x2_t b=__builtin_convertvector(v,bf16x2_t);return __builtin_bit_cast(unsigned,b);}
#define WAIT_BAR(N) asm volatile("s_waitcnt vmcnt(" #N ") lgkmcnt(0)\n\ts_barrier":::"memory")

__device__ __forceinline__ void qkt(f32x16&p0,f32x16&p1,const char*Kslot,const bf16x8*qr,const f32x16&negm,int r32,int hi){
  const char*kb=Kslot+hi*1024+r32*16;
  #pragma unroll
  for(int d0=0;d0<4;++d0){
    const bf16x8 b0=*reinterpret_cast<const bf16x8*>(kb+d0*2048);
    const bf16x8 b1=*reinterpret_cast<const bf16x8*>(kb+d0*2048+512);
    if(d0==0){p0=__builtin_amdgcn_mfma_f32_32x32x16_bf16(b0,qr[0],negm,0,0,0);p1=__builtin_amdgcn_mfma_f32_32x32x16_bf16(b1,qr[0],negm,0,0,0);}
    else{p0=__builtin_amdgcn_mfma_f32_32x32x16_bf16(b0,qr[d0],p0,0,0,0);p1=__builtin_amdgcn_mfma_f32_32x32x16_bf16(b1,qr[d0],p1,0,0,0);}}
}
typedef __attribute__((address_space(3))) const char* lds_cptr;
typedef short v4i16_t __attribute__((ext_vector_type(4)));
__device__ __forceinline__ void kload8(bf16x8*kf,lds_cptr kp){
  kf[0]=*(const __attribute__((address_space(3))) bf16x8*)(kp);      kf[1]=*(const __attribute__((address_space(3))) bf16x8*)(kp+512);
  kf[2]=*(const __attribute__((address_space(3))) bf16x8*)(kp+2048); kf[3]=*(const __attribute__((address_space(3))) bf16x8*)(kp+2560);
  kf[4]=*(const __attribute__((address_space(3))) bf16x8*)(kp+4096); kf[5]=*(const __attribute__((address_space(3))) bf16x8*)(kp+4608);
  kf[6]=*(const __attribute__((address_space(3))) bf16x8*)(kp+6144); kf[7]=*(const __attribute__((address_space(3))) bf16x8*)(kp+6656);
}
__device__ __forceinline__ void kload2(bf16x8*kf,lds_cptr kp,int j){ kf[2*j]=*(const __attribute__((address_space(3))) bf16x8*)(kp+j*2048); kf[2*j+1]=*(const __attribute__((address_space(3))) bf16x8*)(kp+j*2048+512); }
__device__ __forceinline__ s16x4 vtr(lds_cptr p){ return __builtin_bit_cast(s16x4,__builtin_amdgcn_ds_read_tr16_b64_v4i16((__attribute__((address_space(3))) v4i16_t*)p)); }
__device__ __forceinline__ float rowmax(const f32x16&p0,const f32x16&p1){
  float a=max3f(p0[0],p0[1],p1[0]),b=max3f(p0[2],p0[3],p1[1]);a=max3f(a,p1[2],p1[3]);
  #pragma unroll
  for(int r=4;r<16;r+=4){a=max3f(a,p0[r],p0[r+1]);b=max3f(b,p0[r+2],p0[r+3]);a=max3f(a,p1[r],p1[r+1]);b=max3f(b,p1[r+2],p1[r+3]);}
  const float m=max2f(a,b);
  auto rr=__builtin_amdgcn_permlane32_swap(__float_as_uint(m),__float_as_uint(m),false,false);
  return max2f(__uint_as_float(rr[0]),__uint_as_float(rr[1]));
}
__device__ __forceinline__ void pv(f32x16*o,int vb,bf16x8 pa0,bf16x8 pa1,bf16x8 pa2,bf16x8 pa3){
  #pragma unroll
  for(int d0=0;d0<4;++d0){s16x4 lo[4],hi[4];
    #pragma unroll
    for(int ks=0;ks<4;++ks){
      asm volatile("ds_read_b64_tr_b16 %0,%1 offset:%c2":"=&v"(lo[ks]):"v"(vb),"i"(d0*4096+ks*1024):"memory");
      asm volatile("ds_read_b64_tr_b16 %0,%1 offset:%c2":"=&v"(hi[ks]):"v"(vb),"i"(d0*4096+ks*1024+512):"memory");}
    asm volatile("s_waitcnt lgkmcnt(0)":::"memory");SBAR();
    #define PK(k) (bf16x8){lo[k][0],lo[k][1],lo[k][2],lo[k][3],hi[k][0],hi[k][1],hi[k][2],hi[k][3]}
    o[d0]=__builtin_amdgcn_mfma_f32_32x32x16_bf16(pa0,PK(0),o[d0],0,0,0);
    o[d0]=__builtin_amdgcn_mfma_f32_32x32x16_bf16(pa1,PK(1),o[d0],0,0,0);
    o[d0]=__builtin_amdgcn_mfma_f32_32x32x16_bf16(pa2,PK(2),o[d0],0,0,0);
    o[d0]=__builtin_amdgcn_mfma_f32_32x32x16_bf16(pa3,PK(3),o[d0],0,0,0);
    #undef PK
  }
}

#ifndef ATTN_STORE16
#define ATTN_STORE16(p,v) (*(u32x4*)(p)=(v))
#endif
template<int THRL> __device__ __forceinline__ void attn_unit(int b,int hc,int qb,const bf16*Q,const bf16*__restrict__ K,const bf16*__restrict__ V,bf16*O,char*shm){
  const int tid=threadIdx.x,lane=tid&63,r32=lane&31,hi=lane>>5; const int wid=__builtin_amdgcn_readfirstlane(tid>>6);
  const long rowbase=(long)b*SEQ; const int q0=qb*QB;
  const bf16*Qw=Q+(rowbase+q0+wid*QBLK)*DM+hc*D;
  const lds_cfptr btab=(lds_cfptr)((lds_cptr)shm+LDS_BIAS)+(hc>>1)*128;
  const unsigned lds0=(unsigned)(uintptr_t)shm;
  float*wsf=(float*)(shm+LDS_WS)+wid*64;
  const bf16*ksrc=K+(long)((b*16+hc)*128)*4096+wid*512+lane*8;
  const bf16*vsrc=V+(long)((b*8+(hc>>1))*128)*8192+wid*512+lane*8;
  const unsigned kdst=lds0+LDS_K+wid*1024, vdst=lds0+LDS_V+wid*1024;
  #define DMA_K(t,slot) glds16(ksrc+(long)(t)*4096,(unsigned)__builtin_amdgcn_readfirstlane(kdst+(slot)))
  #define DMA_V(t,slot) do{ glds16(vsrc+(long)(t)*8192,(unsigned)__builtin_amdgcn_readfirstlane(vdst+2*(slot))); glds16(vsrc+(long)(t)*8192+4096,(unsigned)__builtin_amdgcn_readfirstlane(vdst+2*(slot)+8192)); }while(0)
  const int vb0=(int)(lds0+LDS_V)+((lane>>4)&1)*32+(lane&3)*8+(4*hi+((lane&15)>>2))*64;
  const char*Kbase=shm+LDS_K; bf16x8 kf[8];
  const lds_cptr shm3=(lds_cptr)shm; const lds_cptr kp0=shm3+LDS_K+hi*1024+r32*16; const lds_cptr vp0=shm3+LDS_V+((lane>>4)&1)*32+(lane&3)*8+(4*hi+((lane&15)>>2))*64;
  const int NT=(q0+QB)/KVBLK;
  DMA_K(0,0);DMA_V(0,0);DMA_K(1,SLOTB);
  bf16x8 qr[4];
  #pragma unroll
  for(int d0=0;d0<4;++d0)qr[d0]=*reinterpret_cast<const bf16x8*>(&Qw[(long)r32*DM+d0*16+hi*8]);
  float mhat=0.f,l_reg=0.f;f32x16 o[4];o[0]=f32x16{};o[1]=f32x16{};o[2]=f32x16{};o[3]=f32x16{};
  const f32x16 zero16=f32x16{};
  const int qrel=wid*QBLK+r32;
  #define CMASK(P0,P1,t) do{int jb_=(t)-(NT-4); if(jb_>=-2&&(32*wid-64*jb_<176||64*jb_+63>32*wid))cmask(P0,P1,jb_,qrel,hi,btab);}while(0)
  bool resc=false;
  #define RESC() do{ if(resc){ asm volatile("s_waitcnt lgkmcnt(0)":::"memory"); \
      _Pragma("unroll") for(int d_=0;d_<4;++d_) _Pragma("unroll") for(int r=0;r<16;++r)o[d_][r]*=wsf[crow(r,hi)]; } }while(0)
  f32x16 pA0,pA1,pB0,pB1;
  int sl_prev=0,sl_cur=0,sl_next=SLOTB;
  #define ROT() do{sl_prev=sl_cur;sl_cur=sl_next;sl_next=(sl_next==(NSLOT-1)*SLOTB)?0:sl_next+SLOTB;}while(0)
  DMA_K(2,2*SLOTB);
  WAIT_BAR(4);
  qkt(pA0,pA1,Kbase,qr,zero16,r32,hi);asm volatile("s_nop 15\n\ts_nop 7":"+v"(pA0),"+v"(pA1));CMASK(pA0,pA1,0);
  { const float rm=rowmax(pA0,pA1); mhat=rm;
    _Pragma("unroll") for(int r=0;r<16;++r){pA0[r]=__builtin_amdgcn_exp2f(pA0[r]-mhat);pA1[r]=__builtin_amdgcn_exp2f(pA1[r]-mhat);} }
  WAIT_BAR(0);
  DMA_K(3,0);DMA_V(1,SLOTB);
  ROT();
  kload8(kf,kp0+sl_cur);
  WAIT_BAR(3);
  s16x4 vl[16],vh[16]; u32x4 pw0,pw1,pw2,pw3;
  #define PKW(P,B) cvtpk_s(P[B],P[B+1])
  #define PAF(k) __builtin_bit_cast(bf16x8,pw##k)
  #define VFR(i) (bf16x8){vl[i][0],vl[i][1],vl[i][2],vl[i][3],vh[i][0],vh[i][1],vh[i][2],vh[i][3]}
  #define PIN(x) asm volatile("":"+v"(x))
  #define MX3(a,b,c) __builtin_fmaxf(__builtin_fmaxf((a),(b)),(c))
  #define GAPA(MF,A0,A1,A2,A3,W0,W1,PW) do{ MF; sacc+=A0; sacc+=A1; sacc+=A2; sacc+=A3; PIN(sacc); W0; W1; PIN(PW); SBAR(); }while(0)
  #define EX(v) __builtin_amdgcn_exp2f(v)
  #define GAPB(MF,X,B,PN,BN) do{ MF; X[B]=EX(X[B]); X[B+1]=EX(X[B+1]); PIN(X); SBAR(); }while(0)
  #define VRL(j) do{ vl[j]=vtr(vp_+(((j)&3)*4096+((j)>>2)*1024)); }while(0)
  #define VRH(j) do{ vh[j]=vtr(vp_+(((j)&3)*4096+((j)>>2)*1024+512)); }while(0)
  #define VR(j) do{ VRL(j); VRH(j); SBAR(); }while(0)
  #define KRD(G,j) do{ if(G){ kload2(kf,kp0+sl_next,j); SBAR(); } }while(0)
  #define PVJ(ks,dq,j) o[dq]=__builtin_amdgcn_mfma_f32_32x32x16_bf16(PAF(ks),VFR(j),o[dq],0,0,0)
  #define STEP(C0,C1,P0,P1,t,GK,GV,GL) do{ SBAR(); \
    const lds_cptr vp_=vp0+2*sl_prev; \
    { const float nm_=-mhat; _Pragma("unroll") for(int r=0;r<16;++r){C0[r]=nm_;C1[r]=nm_;} }   \
    VRL(0); SBAR(); float sacc=(P0[0]+P0[1]); \
    GAPA(C0=__builtin_amdgcn_mfma_f32_32x32x16_bf16(kf[0],qr[0],C0,0,0,0), P0[2],P0[3],P0[4],P0[5],     pw0[0]=PKW(P0,0), pw0[1]=PKW(P0,2), pw0); \
    VRH(0); SBAR(); GAPA(C1=__builtin_amdgcn_mfma_f32_32x32x16_bf16(kf[1],qr[0],C1,0,0,0), P0[6],P0[7],P0[8],P0[9],     pw0[2]=PKW(P0,4), pw0[3]=PKW(P0,6), pw0); \
    VRL(1); SBAR(); GAPA(C0=__builtin_amdgcn_mfma_f32_32x32x16_bf16(kf[2],qr[1],C0,0,0,0),   P0[10],P0[11],P0[12],P0[13], pw1[0]=PKW(P0,8), pw1[1]=PKW(P0,10), pw1); \
    VRH(1); SBAR(); GAPA(C1=__builtin_amdgcn_mfma_f32_32x32x16_bf16(kf[3],qr[1],C1,0,0,0),   P0[14],P0[15],P1[0],P1[1],   pw1[2]=PKW(P0,12),pw1[3]=PKW(P0,14), pw1); \
    VRL(2); SBAR(); GAPA(C0=__builtin_amdgcn_mfma_f32_32x32x16_bf16(kf[4],qr[2],C0,0,0,0),   P1[2],P1[3],P1[4],P1[5],     pw2[0]=PKW(P1,0), pw2[1]=PKW(P1,2), pw2); \
    VRH(2); SBAR(); GAPA(C1=__builtin_amdgcn_mfma_f32_32x32x16_bf16(kf[5],qr[2],C1,0,0,0),   P1[6],P1[7],P1[8],P1[9],     pw2[2]=PKW(P1,4), pw2[3]=PKW(P1,6), pw2); \
    VRL(3); SBAR(); GAPA(C0=__builtin_amdgcn_mfma_f32_32x32x16_bf16(kf[6],qr[3],C0,0,0,0),   P1[10],P1[11],P1[12],P1[13], pw3[0]=PKW(P1,8), pw3[1]=PKW(P1,10), pw3); \
    VRH(3); SBAR(); GAPA(C1=__builtin_amdgcn_mfma_f32_32x32x16_bf16(kf[7],qr[3],C1,0,0,0),   P1[14],P1[15],0.f,0.f,       pw3[2]=PKW(P1,12),pw3[3]=PKW(P1,14), pw3); \
    l_reg+=sacc; \
    if(GK){DMA_K((t)+3,sl_cur);} if(GV){DMA_V((t)+1,sl_next);} \
    CMASK(C0,C1,t); \
    { float a=MX3(C0[0],C0[1],C1[0]),b=MX3(C0[2],C0[3],C1[1]); a=MX3(a,C1[2],C1[3]); \
      _Pragma("unroll") for(int r=4;r<16;r+=4){a=MX3(a,C0[r],C0[r+1]);b=MX3(b,C0[r+2],C0[r+3]);a=MX3(a,C1[r],C1[r+1]);b=MX3(b,C1[r+2],C1[r+3]);} \
      float rm=__builtin_fmaxf(a,b); { auto rr=__builtin_amdgcn_permlane32_swap(__float_as_uint(rm),__float_as_uint(rm),false,false); rm=__builtin_fmaxf(__uint_as_float(rr[0]),__uint_as_float(rr[1])); } \
      resc=false; \
      if(__builtin_expect(__any(rm>(float)THRL),0)){ const float dl=__builtin_fmaxf(rm,0.f); mhat+=dl; \
        _Pragma("unroll") for(int r=0;r<16;++r){C0[r]-=dl;C1[r]-=dl;} \
        const float f=__builtin_amdgcn_exp2f(-dl); l_reg*=f; if(hi==0)wsf[r32]=f; resc=true; } } \
    SBAR(); \
    VR(4);  GAPB(PVJ(0,0,0),  C0,0,  P0,0); \
    VR(5);  GAPB(PVJ(0,1,1),  C0,2,  P0,2); \
    VR(6);  GAPB(PVJ(0,2,2),  C0,4,  P0,4); \
    VR(7);  GAPB(PVJ(0,3,3),  C0,6,  P0,6); \
    VR(8);  GAPB(PVJ(1,0,4),  C0,8,  P0,8); \
    VR(9);  GAPB(PVJ(1,1,5),  C0,10, P0,10); \
    VR(10); GAPB(PVJ(1,2,6),  C0,12, P0,12); \
    VR(11); GAPB(PVJ(1,3,7),  C0,14, P0,14); \
    VR(12); GAPB(PVJ(2,0,8),  C1,0,  P1,0); \
    VR(13); GAPB(PVJ(2,1,9),  C1,2,  P1,2); \
    VR(14); GAPB(PVJ(2,2,10), C1,4,  P1,4); \
    VR(15); GAPB(PVJ(2,3,11), C1,6,  P1,6); \
    KRD(GL,0); GAPB(PVJ(3,0,12), C1,8,  P1,8); \
    KRD(GL,1); GAPB(PVJ(3,1,13), C1,10, P1,10); \
    KRD(GL,2); GAPB(PVJ(3,2,14), C1,12, P1,12); \
    KRD(GL,3); GAPB(PVJ(3,3,15), C1,14, P1,14); \
    }while(0)
  int t=1;
  #undef CMASK
  #define CMASK(P0,P1,t) do{}while(0)
  for(;t+7<NT;t+=2){
    STEP(pB0,pB1,pA0,pA1,t,true,true,true);     WAIT_BAR(3); RESC(); ROT();
    STEP(pA0,pA1,pB0,pB1,t+1,true,true,true);   WAIT_BAR(3); RESC(); ROT();
  }
  #undef CMASK
  #define CMASK(P0,P1,t) do{int jb_=(t)-(NT-4); if(jb_>=-2&&(32*wid-64*jb_<176||64*jb_+63>32*wid))cmask(P0,P1,jb_,qrel,hi,btab);}while(0)
  #define ENDW(tt) do{ if((tt)+3<NT){WAIT_BAR(3);} else if((tt)+2<NT){WAIT_BAR(2);} else {WAIT_BAR(0);} }while(0)
  for(;t+1<NT;t+=2){
    STEP(pB0,pB1,pA0,pA1,t,(t+3<NT),(t+1<NT),(t+1<NT));       ENDW(t);   RESC(); ROT();
    STEP(pA0,pA1,pB0,pB1,t+1,(t+4<NT),(t+2<NT),(t+2<NT));     ENDW(t+1); RESC(); ROT();
  }
  STEP(pB0,pB1,pA0,pA1,NT-1,false,false,false); RESC();
  { float sacc=pB0[0]+pB0[1]; _Pragma("unroll") for(int r=2;r<16;++r)sacc+=pB0[r]; _Pragma("unroll") for(int r=0;r<16;++r)sacc+=pB1[r]; l_reg+=sacc;
    pw0=(u32x4){PKW(pB0,0),PKW(pB0,2),PKW(pB0,4),PKW(pB0,6)};pw1=(u32x4){PKW(pB0,8),PKW(pB0,10),PKW(pB0,12),PKW(pB0,14)};pw2=(u32x4){PKW(pB1,0),PKW(pB1,2),PKW(pB1,4),PKW(pB1,6)};pw3=(u32x4){PKW(pB1,8),PKW(pB1,10),PKW(pB1,12),PKW(pB1,14)};
    SBAR(); pv(o,vb0+2*sl_cur,PAF(0),PAF(1),PAF(2),PAF(3)); }
  #undef PKW
  #undef PAF
  #undef VFR
  #undef PIN
  #undef MX3
  #undef GAPA
  #undef GAPB
  #undef EX
  #undef VRL
  #undef VRH
  #undef VR
  #undef KRD
  #undef PVJ
  #undef STEP
  #undef ENDW
  {auto rr=__builtin_amdgcn_permlane32_swap(__float_as_uint(l_reg),__float_as_uint(l_reg),false,false);l_reg=__uint_as_float(rr[0])+__uint_as_float(rr[1]);}
  if(hi==0)wsf[32+r32]=l_reg;asm volatile("s_waitcnt lgkmcnt(0)":::"memory");
  float rli[16];
  #pragma unroll
  for(int r=0;r<16;++r)rli[r]=__builtin_amdgcn_rcpf(wsf[32+crow(r,hi)]);
  { bf16*stg=(bf16*)(shm+LDS_OST)+wid*2048;
    #pragma unroll
    for(int hp=0;hp<2;++hp){
      #pragma unroll
      for(int r=0;r<16;++r){const int orow=crow(r,hi);
        #pragma unroll
        for(int d0=0;d0<2;++d0)stg[orow*64+d0*32+r32]=__float2bfloat16(o[2*hp+d0][r]*rli[r]);}
      asm volatile("s_waitcnt lgkmcnt(0)":::"memory");
      #pragma unroll
      for(int i=0;i<4;++i){const int row=i*8+(lane>>3),ch=lane&7; const u32x4 v=*(const u32x4*)(stg+row*64+ch*8); ATTN_STORE16(O+pg8::tiled_off((int)(rowbase+q0+wid*QBLK)+row,(hc>>1)*128+hp*64+ch*8,DM),v);}
      asm volatile("s_waitcnt lgkmcnt(0)":::"memory"); } }
  asm volatile("s_waitcnt lgkmcnt(0)\n\ts_barrier":::"memory");
  #undef DMA_K
  #undef DMA_V
  #undef CMASK
  #undef RESC
  #undef ROT
}
constexpr int ATTN_LDS_BYTES=LDS_BYTES;
struct AttnTensors { const bf16* Q; const bf16* K; const bf16* V; bf16* O0; bf16* O1; };
struct AttnUnit { int bh; int qb; };
struct StaticOrder {
  int vcu;
  __device__ __forceinline__ explicit StaticOrder(int grid,int block):vcu((block%8)*(grid/8)+block/8){}
  __device__ __forceinline__ bool next(int i,AttnUnit&u)const{ if(i>=8)return false; const int s=vcu&7,k=i&3; { const int p_=vcu>>3; u.bh=(p_>>3)*16+(p_&7)*2+(i>>2); } u.qb=(k==0)?s:(k==1)?15-s:(k==2)?16+s:31-s; return true; }
  __device__ __forceinline__ void a_ready(const AttnUnit&)const{}
  __device__ __forceinline__ void done(const AttnUnit&)const{}
};
template<class Sched,int THRL=8> __device__ __forceinline__ void attn_phase(char*lds,const AttnTensors&T,const Sched&S){
  AttnUnit u;
  for(int i=0;S.next(i,u);++i){ S.a_ready(u); { const int hc_=u.bh&15; attn_unit<THRL>(u.bh>>4,hc_,u.qb,T.Q,T.K,T.V,(hc_&1)?T.O1:T.O0,lds); } S.done(u); }
}
#undef SBAR
#undef WAIT_BAR
}
namespace cg = cooperative_groups;
constexpr int NWAVES = 8;
constexpr int BATCH = 4, SEQ = 8192, D = 1024, M = BATCH * SEQ, DFF = 2816, PLE = 256, CW = 31;
constexpr size_t MiB = 1u << 20;
constexpr size_t WS_CTL = 0, WS_BT = 1 * MiB  , WS_SSA = 2 * MiB, WS_SSB = 4 * MiB;
constexpr size_t WS_WPW1 = 8 * MiB, WS_WPW2 = 12 * MiB, WS_WQKV = 14 * MiB, WS_WO = 20 * MiB, WS_WGU0 = 22 * MiB, WS_WGU1 = 33 * MiB, WS_WD0 = 44 * MiB, WS_WD1 = 50 * MiB,
                 WS_WPG0 = 56 * MiB, WS_WPG1 = 58 * MiB, WS_WPP0 = 60 * MiB, WS_WPP1 = 61 * MiB;
constexpr size_t WS_PB = 64 * MiB  , WS_HBA = 96 * MiB, WS_HBB = 160 * MiB, WS_F = 224 * MiB  ;
constexpr size_t WS_U = 224 * MiB, WS_V2 = 288 * MiB, WS_Q = 224 * MiB, WS_K = 288 * MiB, WS_V = 352 * MiB, WS_PP = 416 * MiB, WS_O1 = 416 * MiB, WS_END = 480 * MiB;
static_assert(WS_F + (size_t)M * DFF * 2 <= WS_PP && WS_V + (size_t)M * D * 2 <= WS_PP, "ws map");
constexpr int RING_BYTES = 131072, LDS_TOTAL = 147456;
#define GAS __attribute__((address_space(1)))
#define LAS __attribute__((address_space(3)))
typedef unsigned short bf16;
typedef unsigned v4u __attribute__((ext_vector_type(4)));
typedef float f32x4 __attribute__((ext_vector_type(4)));
#define LDS_WAIT() asm volatile("s_waitcnt lgkmcnt(0)" ::: "memory")
__device__ __forceinline__ unsigned f2bf(float f) { unsigned u = __builtin_bit_cast(unsigned, f); return (u + 0x7fffu + ((u >> 16) & 1u)) >> 16; }
__device__ __forceinline__ unsigned pk2(float lo, float hi) { return f2bf(lo) | (f2bf(hi) << 16); }
__device__ __forceinline__ float wave_sum(float v) {
#pragma unroll
    for (int o = 1; o < 64; o <<= 1) v += __shfl_xor(v, o);
    return v;
}
#define XB_TMO      128
#define XB_XCNT(j)  (256  + 64 * (j))
#define XB_XSUB(j)  (1280 + 64 * (j))
#define XB_XGEN(j)  (2304 + 64 * (j))
#define XB_TOP      3328
#define XB_TOPGEN   3392
#define XCD_BAR_WORDS 3456
#define XB_SPIN_CAP (1u << 18)

__device__ __forceinline__ unsigned xb_ld(unsigned* p)              { return __hip_atomic_load(p, __ATOMIC_RELAXED, __HIP_MEMORY_SCOPE_AGENT); }
__device__ __forceinline__ unsigned xb_add(unsigned* p, unsigned v) { return __hip_atomic_fetch_add(p, v, __ATOMIC_RELAXED, __HIP_MEMORY_SCOPE_AGENT); }
__device__ __forceinline__ unsigned xb_xcc_id() { return (unsigned)__builtin_amdgcn_s_getreg((3 << 11) | 20) & 0xFu; }
#define XB_SPIN(cond, bar) do { unsigned _sp = 0; while (cond) { __builtin_amdgcn_s_sleep(1); \
    if ((++_sp & 255u) == 0u) { if (xb_ld(&(bar)[XB_TMO])) break; if (_sp > XB_SPIN_CAP) { atomicAdd(&(bar)[XB_TMO], 1u); break; } } } } while (0)

struct XcdBarrier {
    unsigned* bar; unsigned x;
    volatile LAS unsigned* st;
};

__device__ __forceinline__ XcdBarrier xcd_barrier_post(unsigned* bar, volatile LAS unsigned* st) {
    XcdBarrier b; b.bar = bar; b.x = xb_xcc_id(); b.st = st;
    if (threadIdx.x == 0) (void)xb_add(&bar[XB_XCNT(b.x)], 1u);
    return b;
}
__device__ __forceinline__ void xcd_barrier_complete(unsigned* bar, unsigned x, unsigned& nloc, unsigned& nx) {
    const unsigned G = gridDim.x * gridDim.y * gridDim.z;
    unsigned sum, cnt, mine, sp = 0u;
    for (;;) {
        sum = 0u; cnt = 0u; mine = 0u;
#pragma unroll
        for (unsigned j = 0; j < 16; ++j) { const unsigned c = xb_ld(&bar[XB_XCNT(j)]); sum += c; cnt += (c > 0u) ? 1u : 0u; mine = (j == x) ? c : mine; }
        if (sum == G) break;
        __builtin_amdgcn_s_sleep(1);
        if ((++sp & 255u) == 0u) { if (xb_ld(&bar[XB_TMO])) break; if (sp > XB_SPIN_CAP) { atomicAdd(&bar[XB_TMO], 1u); break; } }
    }
    nloc = mine > 0u ? mine : 1u; nx = cnt > 0u ? cnt : 1u;
}

__device__ __forceinline__ void xcd_barrier(const XcdBarrier& b) {
    asm volatile("s_waitcnt vmcnt(0)" ::: "memory");
    __syncthreads();
    if (threadIdx.x == 0) {
        unsigned* bar = b.bar;
        __builtin_amdgcn_s_waitcnt(0);
        unsigned nloc = b.st[0], nx = b.st[1];
        if (nloc == 0u) { xcd_barrier_complete(bar, b.x, nloc, nx); b.st[0] = nloc; b.st[1] = nx; }
        const unsigned old = xb_add(&bar[XB_XSUB(b.x)], 1u);
        const unsigned gen = old / nloc;
        if (old + 1u == (gen + 1u) * nloc) {
            __builtin_amdgcn_fence(__ATOMIC_RELEASE, "agent");
            asm volatile("s_waitcnt vmcnt(0)" ::: "memory");
            const unsigned og = xb_add(&bar[XB_TOP], 1u);
            const unsigned tg = og / nx;
            if (og + 1u == (tg + 1u) * nx) xb_add(&bar[XB_TOPGEN], 1u);
            else XB_SPIN(xb_ld(&bar[XB_TOPGEN]) == tg, bar);
            __builtin_amdgcn_fence(__ATOMIC_ACQUIRE, "agent");
            xb_add(&bar[XB_XGEN(b.x)], 1u);
            asm volatile("s_waitcnt vmcnt(0)" ::: "memory");
        } else {
            XB_SPIN(xb_ld(&bar[XB_XGEN(b.x)]) == gen, bar);
            __builtin_amdgcn_fence(__ATOMIC_ACQUIRE, "agent");
            asm volatile("s_waitcnt vmcnt(0)" ::: "memory");
        }
    }
    __syncthreads();
}

__device__ const unsigned char T5_BUCKET[128] = {0, 1, 2, 3, 4, 5, 6, 7, 8, 9, 10, 11, 12, 13, 14, 15, 16, 16, 16, 17, 17, 18, 18, 18, 19, 19, 19, 20, 20, 20, 20, 21, 21, 21, 21, 22, 22, 22, 22, 22, 23, 23, 23, 23, 23, 23, 24, 24, 24, 24, 24, 24, 25, 25, 25, 25, 25, 25, 25, 26, 26, 26, 26, 26, 26, 26, 26, 27, 27, 27, 27, 27, 27, 27, 27, 27, 27, 28, 28, 28, 28, 28, 28, 28, 28, 28, 28, 29, 29, 29, 29, 29, 29, 29, 29, 29, 29, 29, 29, 30, 30, 30, 30, 30, 30, 30, 30, 30, 30, 30, 30, 30, 30, 31, 31, 31, 31, 31, 31, 31, 31, 31, 31, 31, 31, 31, 31, 31};

struct Args { const float* in[29]; float* out; unsigned char* ws; int ph_lo, ph_hi; };
enum { I_X = 0, I_P, I_CNG, I_CW1, I_CB1, I_CDW, I_CDB, I_CLG, I_CLB, I_CW2, I_CB2, I_ANG, I_AWQKV, I_AQG, I_AKG, I_LQ1, I_LK1, I_LQ2, I_LK2, I_ASG, I_AWO, I_RB, I_FNG, I_FWG, I_FWU, I_FWD, I_PNG, I_PWG, I_PWP };

__device__ __forceinline__ int dst_row(int mode, int n) {
    if (mode == 0) return n;
    if (mode == 1) return 256 * (n >> 7) + (n & 127);
    if (mode == 2) return 256 * (n >> 7) + 128 + (n & 127);
    if (mode == 3) { const int part = n >> 10, c = n & 1023; return 256 * (c >> 7) + 128 * part + (c & 127); }
    if (n >= 2048) return n;
    { const int sec = n >> 10, c = n & 1023, j = c >> 6, i = c & 63; return sec * 1024 + 256 * (j >> 2) + 128 * (i >> 5) + 32 * (j & 3) + (i & 31); }
}
__device__ __forceinline__ void transpose_item(const float* W, int K, int N, bf16* WT, int mode, const float* gain, LAS float* scr, int item, int lane) {
    const int nblk = N / 32, kb = item / nblk, nb = item % nblk, k0 = 64 * kb, n0 = 32 * nb;
#pragma unroll
    for (int i = 0; i < 32; ++i) { const int kk = 2 * i + (lane >> 5); float w = W[(size_t)(k0 + kk) * N + n0 + (lane & 31)]; if (gain) w *= gain[k0 + kk]; scr[kk * 33 + (lane & 31)] = w; }
    LDS_WAIT(); asm volatile("" ::: "memory");
    const int c = lane & 7;
#pragma unroll
    for (int j = 0; j < 4; ++j) { const int n = (lane >> 3) + 8 * j; const LAS float* s = scr + (8 * c) * 33 + n;
        v4u o; o.x = pk2(s[0 * 33], s[1 * 33]); o.y = pk2(s[2 * 33], s[3 * 33]); o.z = pk2(s[4 * 33], s[5 * 33]); o.w = pk2(s[6 * 33], s[7 * 33]);
        const int p_ = dst_row(mode, n0 + n), pl_ = p_ & 127, x_ = pl_ & 31, R_ = (pl_ & ~31) + 16 * ((x_ >> 2) & 1) + 4 * (x_ >> 3) + (x_ & 3);
        *(GAS v4u*)((GAS unsigned char*)WT + ((size_t)(p_ >> 7) * (K / 64) + (k0 >> 6)) * 16384 + pg8::lds_byte(R_, 8 * c)) = o; }
    LDS_WAIT(); asm volatile("" ::: "memory");
}

__device__ __forceinline__ void p0_prologue(const Args& a, LAS unsigned char* lds, int vcu, int G, int wave, int lane) {
    unsigned char* ws = a.ws;
    LAS float* scr = (LAS float*)(lds + wave * 16384);
    const int gw = vcu * NWAVES + wave, NGW = G * NWAVES;
    constexpr int T_PW1 = 16 * 64, T_SQ = 16 * 32, T_QKV = 16 * 96, T_GU = 16 * 88, T_DN = 44 * 32, T_PP = 4 * 32;
    constexpr int NITEMS = T_PW1 + T_SQ + T_QKV + T_SQ + 4 * T_GU + 2 * T_DN + 2 * T_SQ + 2 * T_PP;
    for (int it = gw; it < NITEMS; it += NGW) {
        int r = it;
#define TR(cnt, W, K_, N_, DST, MODE, GAIN) if (r < (cnt)) { transpose_item((W), (K_), (N_), (bf16*)(ws + (DST)), (MODE), (GAIN), scr, r, lane); continue; } r -= (cnt);
        TR(T_PW1, a.in[I_CW1], D, 2 * D, WS_WPW1, 3, a.in[I_CNG])
        TR(T_SQ, a.in[I_CW2], D, D, WS_WPW2, 0, (const float*)nullptr)
        TR(T_QKV, a.in[I_AWQKV], D, 3 * D, WS_WQKV, 4, a.in[I_ANG])
        TR(T_SQ, a.in[I_AWO], D, D, WS_WO, 0, (const float*)nullptr)
        TR(T_GU, a.in[I_FWG], D, DFF, WS_WGU0, 1, a.in[I_FNG])
        TR(T_GU, a.in[I_FWU], D, DFF, WS_WGU0, 2, a.in[I_FNG])
        TR(T_GU, a.in[I_FWG] + (size_t)D * DFF, D, DFF, WS_WGU1, 1, a.in[I_FNG] + D)
        TR(T_GU, a.in[I_FWU] + (size_t)D * DFF, D, DFF, WS_WGU1, 2, a.in[I_FNG] + D)
        TR(T_DN, a.in[I_FWD], DFF, D, WS_WD0, 0, (const float*)nullptr)
        TR(T_DN, a.in[I_FWD] + (size_t)D * DFF, DFF, D, WS_WD1, 0, (const float*)nullptr)
        TR(T_SQ, a.in[I_PWG], D, D, WS_WPG0, 0, a.in[I_PNG])
        TR(T_SQ, a.in[I_PWG] + (size_t)D * D, D, D, WS_WPG1, 0, a.in[I_PNG] + D)
        TR(T_PP, a.in[I_PWP], PLE, D, WS_WPP0, 0, (const float*)nullptr)
        TR(T_PP, a.in[I_PWP] + (size_t)PLE * D, PLE, D, WS_WPP1, 0, (const float*)nullptr)
#undef TR
    }
    { const float* x = a.in[I_X]; bf16* hb = (bf16*)(ws + WS_HBA); float* ss = (float*)(ws + WS_SSA);
      for (int m0 = gw * 4; m0 < M; m0 += NGW * 4) {
          f32x4 v[4][4]; float s[4];
#pragma unroll
          for (int r = 0; r < 4; ++r) { const GAS f32x4* xr = (const GAS f32x4*)(x + (size_t)(m0 + r) * D) + lane;
#pragma unroll
              for (int j = 0; j < 4; ++j) v[r][j] = xr[64 * j]; }
#pragma unroll
          for (int r = 0; r < 4; ++r) { float t = 0.f;
#pragma unroll
              for (int j = 0; j < 4; ++j) t += (v[r][j].x * v[r][j].x + v[r][j].y * v[r][j].y) + (v[r][j].z * v[r][j].z + v[r][j].w * v[r][j].w);
              s[r] = wave_sum(t); }
#pragma unroll
          for (int r = 0; r < 4; ++r) {
#pragma unroll
              for (int j = 0; j < 4; ++j) *(GAS unsigned long long*)(hb + pg8::tiled_off(m0 + r, 4 * lane + 256 * j, D)) = (unsigned long long)pk2(v[r][j].x, v[r][j].y) | ((unsigned long long)pk2(v[r][j].z, v[r][j].w) << 32);
              if (lane < 16) ss[(size_t)(m0 + r) * 16 + lane] = lane == 0 ? s[r] : 0.f; } } }
    { const GAS f32x4* p = (const GAS f32x4*)a.in[I_P]; GAS unsigned long long* o = (GAS unsigned long long*)(ws + WS_PB); const size_t n4 = (size_t)2 * M * PLE / 4;
      const size_t stride = (size_t)NGW * 64;
      for (size_t i = (size_t)gw * 64 + lane; i < n4; i += 8 * stride) { f32x4 v[8];
#pragma unroll
          for (int k = 0; k < 8; ++k) v[k] = p[i + k * stride];
#pragma unroll
          for (int k = 0; k < 8; ++k) { const size_t e = (i + k * stride) * 4, lay = e / ((size_t)M * PLE), rem = e % ((size_t)M * PLE);
              *(GAS unsigned long long*)((bf16*)(ws + WS_PB) + lay * ((size_t)M * PLE) + pg8::tiled_off((int)(rem / PLE), (int)(rem % PLE), PLE)) = (unsigned long long)pk2(v[k].x, v[k].y) | ((unsigned long long)pk2(v[k].z, v[k].w) << 32); } } }
    if (gw == 0) { const float* rb = a.in[I_RB]; float* bt = (float*)(ws + WS_BT);
        for (int i = lane; i < 8 * 128; i += 64) { const int h = i >> 7, d = i & 127; bt[i] = (rb[T5_BUCKET[d] * 8 + h] - rb[31 * 8 + h]) * 1.4426950408889634f; } }
}

__device__ __forceinline__ void conv_phase(const Args& a, LAS unsigned char* lds, int vcu, int G, int tid, int wave, int lane) {
    const bf16* U = (const bf16*)(a.ws + WS_U); bf16* V2 = (bf16*)(a.ws + WS_V2);
    const float* dw = a.in[I_CDW]; const float* db = a.in[I_CDB]; const float* lg = a.in[I_CLG]; const float* lb = a.in[I_CLB];
    typedef float f32x2 __attribute__((ext_vector_type(2)));
    LAS f32x2* red = (LAS f32x2*)lds;
    LAS f32x2* stat = (LAS f32x2*)(lds + 4096);
    const int c0 = 2 * tid;
    f32x2 w[CW];
#pragma unroll
    for (int j = 0; j < CW; ++j) w[j] = *(const f32x2*)(dw + j * D + c0);
    const f32x2 bias = *(const f32x2*)(db + c0), g2 = *(const f32x2*)(lg + c0), b2 = *(const f32x2*)(lb + c0);
    for (int ch = vcu; ch < M / 32; ch += G) {
        const int t0 = ch * 32, tb = t0 & (SEQ - 1);
        unsigned u[62];
#pragma unroll
        for (int i = 0; i < 62; ++i) { const int dt = i - 30; u[i] = (tb + dt >= 0) ? *(const unsigned*)(U + (size_t)(t0 + dt) * D + c0) : 0u; }
        f32x2 o[32];
#pragma unroll
        for (int i = 0; i < 32; ++i) { f32x2 acc = bias;
#pragma unroll
            for (int j = 0; j < CW; ++j) { const unsigned uu = u[i + j]; f32x2 x; x.x = __uint_as_float(uu << 16); x.y = __uint_as_float(uu & 0xffff0000u); acc += w[j] * x; }
            o[i] = acc; }
        { float v[64];
#pragma unroll
            for (int i = 0; i < 32; ++i) { v[2 * i] = o[i].x + o[i].y; v[2 * i + 1] = o[i].x * o[i].x + o[i].y * o[i].y; }
#define RS_STEP(m_, n_) { const bool up_ = (lane & (m_)) != 0; _Pragma("unroll") for (int j = 0; j < (n_); ++j) { const float a_ = v[j], b_ = v[j + (n_)]; const float send_ = up_ ? a_ : b_, keep_ = up_ ? b_ : a_; v[j] = keep_ + __shfl_xor(send_, (m_)); } }
            RS_STEP(32, 32) RS_STEP(16, 16) RS_STEP(8, 8) RS_STEP(4, 4) RS_STEP(2, 2) RS_STEP(1, 1)
#undef RS_STEP
            ((LAS float*)red)[wave * 64 + lane] = v[0]; }
        __syncthreads();
        if (tid < 32) { float s = 0.f, q = 0.f;
#pragma unroll
            for (int wv = 0; wv < 8; ++wv) { const f32x2 r = red[wv * 32 + tid]; s += r.x; q += r.y; }
            const float mean = s * (1.0f / D), var = fmaxf(q * (1.0f / D) - mean * mean, 0.f);
            stat[tid] = (f32x2){mean, __builtin_amdgcn_rsqf(var + 1e-6f)}; }
        __syncthreads();
#pragma unroll
        for (int i = 0; i < 32; ++i) { const f32x2 st = stat[i]; f32x2 y = (o[i] - st.x) * st.y * g2 + b2;
            y.x = y.x * pg8::fast_sigmoid(y.x); y.y = y.y * pg8::fast_sigmoid(y.y);
            *(unsigned*)(V2 + pg8::tiled_off(t0 + i, c0, D)) = pk2(y.x, y.y); }
        __syncthreads();
    }
}

__device__ __forceinline__ void combine_local(const Args& a, int vcu, int wave, int lane) {
    constexpr float LINIT = 0.35550906759f;
    bf16* O0 = (bf16*)(a.ws + WS_HBA); const bf16* O1 = (const bf16*)(a.ws + WS_O1);
    const float d1 = wave_sum(a.in[I_LQ1][lane] * a.in[I_LK1][lane]), d2 = wave_sum(a.in[I_LQ2][lane] * a.in[I_LK2][lane]);
    const float lam = __expf(d1) - __expf(d2) + LINIT;
    float g[16];
#pragma unroll
    for (int e = 0; e < 16; ++e) g[e] = a.in[I_ASG][(lane & 7) * 16 + e] * (1.0f - LINIT);
    const int p = vcu >> 3, b = p >> 3, h = p & 7, s = vcu & 7;
#pragma unroll 1
    for (int k = 0; k < 4; ++k) { const int qb = (k == 0) ? s : (k == 1) ? 15 - s : (k == 2) ? 16 + s : 31 - s;
#pragma unroll 2
        for (int it = 0; it < 4; ++it) { const size_t off = pg8::tiled_off(b * SEQ + 256 * qb + 32 * wave + 8 * it + (lane >> 3), h * 128 + (lane & 7) * 16, D);
            const v4u* p0 = (const v4u*)(O0 + off); const v4u* p1 = (const v4u*)(O1 + off);
            const v4u a0 = p0[0], a1 = p0[1], b0 = p1[0], b1 = p1[1];
            const unsigned aw[8] = {a0.x, a0.y, a0.z, a0.w, a1.x, a1.y, a1.z, a1.w}, bw[8] = {b0.x, b0.y, b0.z, b0.w, b1.x, b1.y, b1.z, b1.w};
            float o[16]; float ssq = 0.f;
#pragma unroll
            for (int e = 0; e < 8; ++e) { o[2 * e] = __uint_as_float(aw[e] << 16) - lam * __uint_as_float(bw[e] << 16); o[2 * e + 1] = __uint_as_float(aw[e] & 0xffff0000u) - lam * __uint_as_float(bw[e] & 0xffff0000u);
                ssq += o[2 * e] * o[2 * e] + o[2 * e + 1] * o[2 * e + 1]; }
            ssq += __shfl_xor(ssq, 1); ssq += __shfl_xor(ssq, 2); ssq += __shfl_xor(ssq, 4);
            const float r = __builtin_amdgcn_rsqf(ssq * (1.0f / 128.0f) + 1e-6f);
            v4u w0, w1;
            w0.x = pk2(o[0] * r * g[0], o[1] * r * g[1]); w0.y = pk2(o[2] * r * g[2], o[3] * r * g[3]); w0.z = pk2(o[4] * r * g[4], o[5] * r * g[5]); w0.w = pk2(o[6] * r * g[6], o[7] * r * g[7]);
            w1.x = pk2(o[8] * r * g[8], o[9] * r * g[9]); w1.y = pk2(o[10] * r * g[10], o[11] * r * g[11]); w1.z = pk2(o[12] * r * g[12], o[13] * r * g[13]); w1.w = pk2(o[14] * r * g[14], o[15] * r * g[15]);
            v4u* q0 = (v4u*)(O0 + off); q0[0] = w0; q0[1] = w1; } }
}

#ifndef MK_PER_PHASE
#define MK_PER_PHASE 0
#endif
constexpr int N_PHASES = 15;
__global__ void __launch_bounds__(NWAVES * 64, 2) mega_fwd(Args args) {
    extern __shared__ __attribute__((aligned(16))) unsigned char lds_raw[];
    cg::grid_group grid = cg::this_grid();
    LAS unsigned char* lds = (LAS unsigned char*)lds_raw;
    const int tid = threadIdx.x, lane = tid & 63, wave = __builtin_amdgcn_readfirstlane(tid >> 6);
    const int G = gridDim.x, bx = blockIdx.x, vcu = (G % 8 == 0) ? (bx % 8) * (G / 8) + bx / 8 : bx;
    unsigned char* ws = args.ws;
    const int lo = args.ph_lo, hi = args.ph_hi;
    volatile LAS unsigned* MISC = (volatile LAS unsigned*)(lds + RING_BYTES + 64);
    if (tid < 2) MISC[tid] = 0u;
    __syncthreads();
    const XcdBarrier bar = xcd_barrier_post((unsigned*)(ws + WS_CTL), MISC);
    if (lo < 0) grid.sync();
#ifndef ONLY
#define ONLY -1
#endif
#define IN(k) (lo <= (k) && (k) < hi && (ONLY < 0 || ONLY == (k)))
#define SEAM(k) do { if (IN(k) && IN((k) + 1)) xcd_barrier(bar); } while (0)
    bf16* HBA = (bf16*)(ws + WS_HBA); bf16* HBB = (bf16*)(ws + WS_HBB); float* SSA = (float*)(ws + WS_SSA); float* SSB = (float*)(ws + WS_SSB);
    float* H = args.out;
    typedef pg8::StaticOrder SO;
#define RUN_GEMM_RM(EPI, A_, B_, N_, K_, E_) do { pg8::Gemm g_{(const bf16*)(A_), (const bf16*)(ws + (B_)), M, (N_), (K_)}; SO S_; S_.init(M, (N_), G, bx); \
        pg8::gemm_phase<EPI, SO, PG8_ALIGN, PG8_SP2, false>(lds, g_, S_, (E_)); } while (0)
#define RUN_GEMM(EPI, A_, B_, N_, K_, E_) do { pg8::Gemm g_{(const bf16*)(A_), (const bf16*)(ws + (B_)), M, (N_), (K_)}; SO S_; S_.init(M, (N_), G, bx); \
        pg8::gemm_phase<EPI, SO, PG8_ALIGN, PG8_SP2>(lds, g_, S_, (E_)); } while (0)

#ifndef NO_PRO
    if (IN(0)) { p0_prologue(args, lds, vcu, G, wave, lane); }
#endif
    SEAM(0);
    if (IN(1)) {
        pg8::EpiGated<0> E{(bf16*)(ws + WS_U), D, SSA, args.in[I_CB1], args.in[I_CB1] + D};
        RUN_GEMM(pg8::EpiGated<0>, HBA, WS_WPW1, 2 * D, D, E);
    }
    SEAM(1);
    #ifndef NO_CONV
    if (IN(2)) { __syncthreads(); conv_phase(args, lds, vcu, G, tid, wave, lane); }
#endif
    SEAM(2);
    if (IN(3)) {
        typedef pg8::EpiRes<0, true, false> EP; EP E{args.in[I_X], nullptr, nullptr, HBA, SSA, args.in[I_CB2], nullptr, nullptr};
        RUN_GEMM(EP, ws + WS_V2, WS_WPW2, D, D, E);
    }
    SEAM(3);
    if (IN(4)) {
        pg8::EpiGated<1> E{(bf16*)(ws + WS_F), DFF, SSA, nullptr, nullptr};
        RUN_GEMM(pg8::EpiGated<1>, HBA, WS_WGU0, 2 * DFF, D, E);
    }
    SEAM(4);
    if (IN(5)) {
        typedef pg8::EpiRes<0, false, false> EP; EP E{nullptr, HBA, nullptr, HBA, SSA, nullptr, nullptr, nullptr};
        RUN_GEMM(EP, ws + WS_F, WS_WD0, D, DFF, E);
        pg8::EpiPlain E2{(bf16*)(ws + WS_PP), D};
        RUN_GEMM(pg8::EpiPlain, ws + WS_PB, WS_WPP0, D, PLE, E2);
    }
    SEAM(5);
    if (IN(6)) {
        typedef pg8::EpiRes<1, false, false> EP; EP E{nullptr, HBA, nullptr, HBB, SSB, nullptr, SSA, (const bf16*)(ws + WS_PP)};
        RUN_GEMM(EP, HBA, WS_WPG0, D, D, E);
    }
    SEAM(6);
    if (IN(7)) {
        pg8::EpiQKV E{(bf16*)(ws + WS_Q), (bf16*)(ws + WS_K), (bf16*)(ws + WS_V), SSB, args.in[I_AQG], args.in[I_AKG], attn_body::C2};
        RUN_GEMM(pg8::EpiQKV, HBB, WS_WQKV, 3 * D, D, E);
    }
    SEAM(7);
    if (IN(8)) {
        __syncthreads();
        { const float* bt = (const float*)(ws + WS_BT); LAS float* dst = (LAS float*)(lds + attn_body::LDS_BIAS); for (int i = tid; i < 1024; i += NWAVES * 64) dst[i] = bt[i]; }
        asm volatile("s_waitcnt vmcnt(0) lgkmcnt(0)" ::: "memory"); __syncthreads();
        const attn_body::AttnTensors AT{(const attn_body::bf16*)(ws + WS_Q), (const attn_body::bf16*)(ws + WS_K), (const attn_body::bf16*)(ws + WS_V), (attn_body::bf16*)(ws + WS_HBA), (attn_body::bf16*)(ws + WS_O1)};
        const attn_body::StaticOrder S(G, bx);
#ifndef NO_ATTN
        attn_body::attn_phase<attn_body::StaticOrder>((char*)lds_raw, AT, S);
#endif
        asm volatile("s_waitcnt vmcnt(0)" ::: "memory"); __builtin_amdgcn_fence(__ATOMIC_ACQ_REL, "workgroup"); __syncthreads();
        combine_local(args, vcu, wave, lane);
    }
    SEAM(8);
    if (IN(10)) {
        typedef pg8::EpiRes<0, false, false> EP; EP E{nullptr, HBB, nullptr, HBB, SSB, nullptr, nullptr, nullptr};
        RUN_GEMM(EP, HBA, WS_WO, D, D, E);
    }
    SEAM(10);
    if (IN(11)) {
        pg8::EpiGated<1> E{(bf16*)(ws + WS_F), DFF, SSB, nullptr, nullptr};
        RUN_GEMM(pg8::EpiGated<1>, HBB, WS_WGU1, 2 * DFF, D, E);
    }
    SEAM(11);
    if (IN(12)) {
        typedef pg8::EpiRes<0, false, false> EP; EP E{nullptr, HBB, nullptr, HBB, SSB, nullptr, nullptr, nullptr};
        RUN_GEMM(EP, ws + WS_F, WS_WD1, D, DFF, E);
        pg8::EpiPlain E2{(bf16*)(ws + WS_PP), D};
        RUN_GEMM(pg8::EpiPlain, ws + WS_PB + (size_t)M * PLE * 2, WS_WPP1, D, PLE, E2);
    }
    SEAM(12);
    if (IN(13)) {
        typedef pg8::EpiRes<1, false, true> EP; EP E{nullptr, HBB, H, nullptr, nullptr, nullptr, SSB, (const bf16*)(ws + WS_PP)};
        RUN_GEMM(EP, HBB, WS_WPG1, D, D, E);
    }
#undef IN
#undef SEAM
#undef RUN_GEMM
}

extern "C" void kernel_launch(void* const* d_in, const int* in_sizes, int n_in, void* d_out, int out_size, void* d_ws, size_t ws_size, hipStream_t stream) {
    static int grid = 0;
    if (grid == 0) {
        if (n_in != 29 || in_sizes[0] != M * D || out_size != M * D || ws_size < WS_END) { fprintf(stderr, "kernel_launch: unexpected shapes / workspace (n_in %d, ws %zu)\n", n_in, ws_size); grid = -1; return; }
        int dev = 0, cus = 0, per_cu = 0;
        if (hipGetDevice(&dev) != hipSuccess || hipDeviceGetAttribute(&cus, hipDeviceAttributeMultiprocessorCount, dev) != hipSuccess) { grid = -1; return; }
        if (hipFuncSetAttribute((const void*)mega_fwd, hipFuncAttributeMaxDynamicSharedMemorySize, LDS_TOTAL) != hipSuccess) { fprintf(stderr, "hipFuncSetAttribute failed\n"); grid = -1; return; }
        if (hipOccupancyMaxActiveBlocksPerMultiprocessor(&per_cu, (const void*)mega_fwd, NWAVES * 64, LDS_TOTAL) != hipSuccess || per_cu < 1) { fprintf(stderr, "occupancy query: %d\n", per_cu); per_cu = 1; }
        (void)hipGetLastError();
        grid = cus * per_cu;
        fprintf(stderr, "kernel_launch: grid %d (cus %d x %d)\n", grid, cus, per_cu);
    }
    if (grid < 0) return;
    if (hipMemsetAsync((char*)d_ws + WS_CTL, 0, 65536, stream) != hipSuccess) { fprintf(stderr, "memset failed\n"); return; }
    Args a{};
    for (int i = 0; i < 29; ++i) a.in[i] = (const float*)d_in[i];
    a.out = (float*)d_out; a.ws = (unsigned char*)d_ws;
    void* kargs[] = {&a};
#if MK_PER_PHASE
    for (int ph = 0; ph < N_PHASES - 1; ++ph) { a.ph_lo = ph; a.ph_hi = ph + 1;
        hipError_t e = hipLaunchCooperativeKernel((const void*)mega_fwd, dim3(grid), dim3(NWAVES * 64), kargs, LDS_TOTAL, stream);
        if (e != hipSuccess) { fprintf(stderr, "launch %d failed: %s\n", ph, hipGetErrorString(e)); break; } }
#else
    a.ph_lo = 0; a.ph_hi = N_PHASES;
    hipError_t e = hipLaunchCooperativeKernel((const void*)mega_fwd, dim3(grid), dim3(NWAVES * 64), kargs, LDS_TOTAL, stream);
    if (e != hipSuccess) fprintf(stderr, "cooperative launch failed: %s (grid %d)\n", hipGetErrorString(e), grid);
#endif
}
```

```cpp
#include <hip/hip_runtime.h>
#include <hip/hip_cooperative_groups.h>
#include <cstdio>
#include <cstdint>
namespace pg8 {
#define PG8_LAS __attribute__((address_space(3)))
typedef unsigned short bf16_t;
typedef short bf16x8 __attribute__((ext_vector_type(8)));
typedef float f32x4 __attribute__((ext_vector_type(4)));
typedef unsigned u32x4 __attribute__((ext_vector_type(4)));
constexpr int BM = 256, BK = 64, HALF = 128, HTB = HALF * BK * 2  , STAGE_BYTES = 8 * HTB, NXCD = 8, WGM = 8;

__host__ __device__ __forceinline__ int lds_byte(int r, int c) { const int st = (r >> 4) * 2 + (c >> 5), rr = r & 15, cc = c & 31, ob = rr * 64 + cc * 2; return st * 1024 + (ob ^ (((ob >> 9) & 1) << 5)); }
__host__ __device__ __forceinline__ void stage_rc(int b, int& R, int& C) { const int st = b / 1024, sb = b % 1024, swz = sb ^ (((sb >> 9) & 1) << 5); R = (st >> 1) * 16 + swz / 64; C = (st & 1) * 32 + (swz % 64) / 2; }
__host__ __device__ __forceinline__ int perm32(int rho) { const int n = rho >> 4, i = rho & 15; return 8 * (i >> 2) + 4 * n + (i & 3); }

__host__ __device__ __forceinline__ size_t tiled_off(int row, int col, int K) { return ((size_t)(row >> 7) * (K >> 6) + (col >> 6)) * 8192 + (lds_byte(row & 127, col & 63) >> 1); }
struct Unit { int pm, pn; };
struct Gemm { const bf16_t* A; const bf16_t* Bt; int M, N, K; };

struct StaticOrder {
    int nM, nN, nwg, G, c;
    __host__ __device__ void init(int M, int N, int G_, int c_) { nM = M / BM; nN = N / BM; nwg = nM * nN; G = G_; c = c_; }
    __host__ __device__ bool next(int i, Unit& u) const {
        const long L = (long)i * G + c; if (L >= nwg) return false;
        int wgid = (int)L; { const int q = nwg / NXCD, r = nwg % NXCD, xcd = wgid % NXCD, off = wgid / NXCD; wgid = (xcd < r ? xcd * (q + 1) : r * (q + 1) + (xcd - r) * q) + off; }
        const int nig = WGM * nN, gid = wgid / nig, fm = gid * WGM, gsz = (nM - fm) < WGM ? (nM - fm) : WGM;
        u.pm = fm + ((wgid % nig) % gsz); u.pn = (wgid % nig) / gsz; return true;
    }
    __device__ __forceinline__ void a_ready(const Unit&) const {}
    __device__ __forceinline__ void done(const Unit&) const {}
};

__device__ __forceinline__ unsigned cvt_pk_bf16(float lo, float hi) { unsigned r; asm volatile("v_cvt_pk_bf16_f32 %0, %1, %2" : "=v"(r) : "v"(lo), "v"(hi)); return r; }
typedef float f32x2 __attribute__((ext_vector_type(2)));
__device__ __forceinline__ float fast_sigmoid(float x) { return __builtin_amdgcn_rcpf(1.0f + __builtin_amdgcn_exp2f(x * -1.4426950408889634f)); }
__device__ __forceinline__ void load_rstd(const PG8_LAS float* rtab, int wr, int fr, float (&rs)[2][4]) {
#pragma unroll
    for (int ai = 0; ai < 2; ++ai)
#pragma unroll
        for (int m = 0; m < 4; ++m) rs[ai][m] = rtab[ai * HALF + wr * 64 + m * 16 + fr];
}
template <int MODE> struct EpiGated {
    static constexpr bool PERM = true, AFTER_DRAIN = false, RSTD = true;
    bf16_t* O; int ldc; const float* SS; const float* b0; const float* b1;
    __device__ __forceinline__ const float* rstd_src() const { return SS; }
    __device__ __forceinline__ void operator()(const f32x4 (&acc)[2][2][4][2], const Unit& u, int wr, int wc, int fr, int fq, const PG8_LAS float* rtab) const {
        const int row0 = u.pm * BM + wr * 64 + fr, lcol = u.pn * HALF + wc * 32 + 8 * fq;
        float rs[2][4]; load_rstd(rtab, wr, fr, rs);
        f32x4 bv[2], bg[2];
#pragma unroll
        for (int n = 0; n < 2; ++n) { bv[n] = (MODE == 0) ? *(const f32x4*)(b0 + lcol + 4 * n) : (f32x4){0.f, 0.f, 0.f, 0.f}; bg[n] = (MODE == 0) ? *(const f32x4*)(b1 + lcol + 4 * n) : (f32x4){0.f, 0.f, 0.f, 0.f}; }
#pragma unroll
        for (int ai = 0; ai < 2; ++ai)
#pragma unroll
            for (int m = 0; m < 4; ++m) { const float r = rs[ai][m]; float o[8];
#pragma unroll
                for (int n = 0; n < 2; ++n) { const f32x4 a = acc[ai][0][m][n] * r + bv[n], g = acc[ai][1][m][n] * r + bg[n];
#pragma unroll
                    for (int e = 0; e < 4; ++e) o[4 * n + e] = (MODE == 0) ? a[e] * fast_sigmoid(g[e]) : a[e] * fast_sigmoid(a[e]) * g[e]; }
                u32x4 w; w.x = cvt_pk_bf16(o[0], o[1]); w.y = cvt_pk_bf16(o[2], o[3]); w.z = cvt_pk_bf16(o[4], o[5]); w.w = cvt_pk_bf16(o[6], o[7]);
                if (MODE == 1) *(u32x4*)(O + tiled_off(row0 + ai * HALF + m * 16, lcol, ldc)) = w;
                else *(u32x4*)(O + (size_t)(row0 + ai * HALF + m * 16) * ldc + lcol) = w; }
    }
};
template <int MODE, bool BASEF32, bool OUTF32> struct EpiRes {
    static constexpr bool PERM = true, AFTER_DRAIN = false, RSTD = (MODE == 1);
    __device__ __forceinline__ const float* rstd_src() const { return SSin; }
    const float* base; const bf16_t* baseh; float* out; bf16_t* hb; float* SSout; const float* bias; const float* SSin; const bf16_t* pp;
    struct Grp { f32x4 b[2][2]; u32x4 h[2]; u32x4 p[2]; };
    __device__ __forceinline__ void load_grp(Grp& g, int row, int col0) const {
#pragma unroll
        for (int bj = 0; bj < 2; ++bj) { const size_t off = (size_t)row * 1024 + col0 + bj * HALF;
            if (BASEF32) { g.b[bj][0] = *(const f32x4*)(base + off); g.b[bj][1] = *(const f32x4*)(base + off + 4); }
            else g.h[bj] = *(const u32x4*)(baseh + tiled_off(row, col0 + bj * HALF, 1024));
            if (MODE == 1) g.p[bj] = *(const u32x4*)(pp + tiled_off(row, col0 + bj * HALF, 1024)); }
    }
    __device__ __forceinline__ void operator()(const f32x4 (&acc)[2][2][4][2], const Unit& u, int wr, int wc, int fr, int fq, const PG8_LAS float* rtab) const {
        const int row0 = u.pm * BM + wr * 64 + fr, col0 = u.pn * BM + wc * 32 + 8 * fq;
        f32x4 bv[2][2];
#pragma unroll
        for (int bj = 0; bj < 2; ++bj)
#pragma unroll
            for (int n = 0; n < 2; ++n) bv[bj][n] = (MODE == 0 && bias) ? *(const f32x4*)(bias + col0 + bj * HALF + 4 * n) : (f32x4){0.f, 0.f, 0.f, 0.f};
        Grp cur, nxt; load_grp(cur, row0, col0);
#pragma unroll
        for (int gi = 0; gi < 8; ++gi) { const int ai = gi >> 2, m = gi & 3; const int row = row0 + ai * HALF + m * 16; float ssq = 0.f;
            if (gi < 7) load_grp(nxt, row0 + ((gi + 1) >> 2) * HALF + ((gi + 1) & 3) * 16, col0);
            float rsr = 0.f;
            if (MODE == 1) rsr = rtab[ai * HALF + wr * 64 + m * 16 + fr];
#pragma unroll
            for (int bj = 0; bj < 2; ++bj) { const size_t off = (size_t)row * 1024 + col0 + bj * HALF;
                f32x4 v0, v1;
                if (BASEF32) { v0 = cur.b[bj][0]; v1 = cur.b[bj][1]; }
                else { const u32x4 hw = cur.h[bj];
                    v0 = (f32x4){__uint_as_float(hw.x << 16), __uint_as_float(hw.x & 0xffff0000u), __uint_as_float(hw.y << 16), __uint_as_float(hw.y & 0xffff0000u)};
                    v1 = (f32x4){__uint_as_float(hw.z << 16), __uint_as_float(hw.z & 0xffff0000u), __uint_as_float(hw.w << 16), __uint_as_float(hw.w & 0xffff0000u)}; }
                if (MODE == 0) { v0 += acc[ai][bj][m][0] + bv[bj][0]; v1 += acc[ai][bj][m][1] + bv[bj][1]; }
                else { const u32x4 pw = cur.p[bj]; const f32x4 a0 = acc[ai][bj][m][0] * rsr, a1 = acc[ai][bj][m][1] * rsr;
                    v0[0] += fast_sigmoid(a0[0]) * __uint_as_float(pw.x << 16); v0[1] += fast_sigmoid(a0[1]) * __uint_as_float(pw.x & 0xffff0000u);
                    v0[2] += fast_sigmoid(a0[2]) * __uint_as_float(pw.y << 16); v0[3] += fast_sigmoid(a0[3]) * __uint_as_float(pw.y & 0xffff0000u);
                    v1[0] += fast_sigmoid(a1[0]) * __uint_as_float(pw.z << 16); v1[1] += fast_sigmoid(a1[1]) * __uint_as_float(pw.z & 0xffff0000u);
                    v1[2] += fast_sigmoid(a1[2]) * __uint_as_float(pw.w << 16); v1[3] += fast_sigmoid(a1[3]) * __uint_as_float(pw.w & 0xffff0000u); }
                if (OUTF32) { *(f32x4*)(out + off) = v0; *(f32x4*)(out + off + 4) = v1; }
                else { u32x4 w; w.x = cvt_pk_bf16(v0[0], v0[1]); w.y = cvt_pk_bf16(v0[2], v0[3]); w.z = cvt_pk_bf16(v1[0], v1[1]); w.w = cvt_pk_bf16(v1[2], v1[3]);
                    *(u32x4*)(hb + tiled_off(row, col0 + bj * HALF, 1024)) = w;
                    ssq += (v0[0] * v0[0] + v0[1] * v0[1]) + (v0[2] * v0[2] + v0[3] * v0[3]) + (v1[0] * v1[0] + v1[1] * v1[1]) + (v1[2] * v1[2] + v1[3] * v1[3]); } }
            if (!OUTF32) { ssq += __shfl_xor(ssq, 16); ssq += __shfl_xor(ssq, 32);
                if (fq == 0) SSout[(size_t)row * 16 + u.pn * 4 + wc] = ssq; }
            asm volatile("" ::: "memory");
            cur = nxt; }
    }
};
struct EpiQKV {
    static constexpr bool PERM = true, AFTER_DRAIN = false, RSTD = true;
    __device__ __forceinline__ const float* rstd_src() const { return SS; }
    bf16_t* Q; bf16_t* K; bf16_t* V; const float* SS; const float* qg; const float* kg; float c2;
    __device__ __forceinline__ void operator()(const f32x4 (&acc)[2][2][4][2], const Unit& u, int wr, int wc, int fr, int fq, const PG8_LAS float* rtab) const {
        const int row0 = u.pm * BM + wr * 64 + fr; const int sec = u.pn >> 2, pt = u.pn & 3;
        float rs[2][4]; load_rstd(rtab, wr, fr, rs);
        if (sec == 2) {
            const int col0 = pt * BM + wc * 32 + 8 * fq;
#pragma unroll
            for (int ai = 0; ai < 2; ++ai)
#pragma unroll
                for (int m = 0; m < 4; ++m) { const float r = rs[ai][m];
#pragma unroll
                    for (int bj = 0; bj < 2; ++bj) { const f32x4 v0 = acc[ai][bj][m][0] * r, v1 = acc[ai][bj][m][1] * r;
                        u32x4 w; w.x = cvt_pk_bf16(v0[0], v0[1]); w.y = cvt_pk_bf16(v0[2], v0[3]); w.z = cvt_pk_bf16(v1[0], v1[1]); w.w = cvt_pk_bf16(v1[2], v1[3]);
                        const int row = row0 + ai * HALF + m * 16, b_ = row >> 13, s_ = row & 8191, h_ = 2 * pt + bj;
                        *(u32x4*)(V + ((size_t)((b_ * 8 + h_) * 128 + (s_ >> 6))) * 8192 + wc * 2048 + (s_ & 63) * 32 + fq * 8) = w; } }
        } else {
            bf16_t* O = sec == 0 ? Q : K; const float* g = sec == 0 ? qg : kg; const float sc = sec == 0 ? c2 : 1.0f;
            f32x4 gv[2][2];
#pragma unroll
            for (int bj = 0; bj < 2; ++bj)
#pragma unroll
                for (int n = 0; n < 2; ++n) gv[bj][n] = *(const f32x4*)(g + 32 * bj + 8 * fq + 4 * n) * sc;
            const int lcol = 64 * (4 * pt + wc) + 8 * fq;
#pragma unroll
            for (int ai = 0; ai < 2; ++ai)
#pragma unroll
                for (int m = 0; m < 4; ++m) { const float r = rs[ai][m]; float ssq = 0.f;
#pragma unroll
                    for (int bj = 0; bj < 2; ++bj)
#pragma unroll
                        for (int n = 0; n < 2; ++n) { const f32x4 a = acc[ai][bj][m][n]; ssq += (a[0] * a[0] + a[1] * a[1]) + (a[2] * a[2] + a[3] * a[3]); }
                    ssq += __shfl_xor(ssq, 16); ssq += __shfl_xor(ssq, 32);
                    const float s = r * __builtin_amdgcn_rsqf(r * r * ssq * (1.0f / 64.0f) + 1e-6f);
#pragma unroll
                    for (int bj = 0; bj < 2; ++bj) { const f32x4 v0 = acc[ai][bj][m][0] * s * gv[bj][0], v1 = acc[ai][bj][m][1] * s * gv[bj][1];
                        u32x4 w; w.x = cvt_pk_bf16(v0[0], v0[1]); w.y = cvt_pk_bf16(v0[2], v0[3]); w.z = cvt_pk_bf16(v1[0], v1[1]); w.w = cvt_pk_bf16(v1[2], v1[3]);
                        const int row = row0 + ai * HALF + m * 16;
                        if (sec == 0) *(u32x4*)(O + (size_t)row * 1024 + lcol + 32 * bj) = w;
                        else { const int b_ = row >> 13, s_ = row & 8191; *(u32x4*)(O + ((size_t)((b_ * 16 + 4 * pt + wc) * 128 + (s_ >> 6))) * 4096 + (4 * bj + fq) * 512 + (s_ & 63) * 8) = w; } } }
        }
    }
};
struct EpiPlain {
    static constexpr bool PERM = true, AFTER_DRAIN = false, RSTD = false;
    __device__ __forceinline__ const float* rstd_src() const { return nullptr; }
    bf16_t* O; int ldc;
    __device__ __forceinline__ void operator()(const f32x4 (&acc)[2][2][4][2], const Unit& u, int wr, int wc, int fr, int fq, const PG8_LAS float* rtab) const {
        const int row0 = u.pm * BM + wr * 64 + fr, col0 = u.pn * BM + wc * 32 + 8 * fq;
#pragma unroll
        for (int ai = 0; ai < 2; ++ai)
#pragma unroll
            for (int m = 0; m < 4; ++m)
#pragma unroll
                for (int bj = 0; bj < 2; ++bj) { const f32x4 v0 = acc[ai][bj][m][0], v1 = acc[ai][bj][m][1];
                    u32x4 w; w.x = cvt_pk_bf16(v0[0], v0[1]); w.y = cvt_pk_bf16(v0[2], v0[3]); w.z = cvt_pk_bf16(v1[0], v1[1]); w.w = cvt_pk_bf16(v1[2], v1[3]);
                    *(u32x4*)(O + tiled_off(row0 + ai * HALF + m * 16, col0 + bj * HALF, ldc)) = w; }
    }
};
template <class Epi, class Sched, bool ALIGN_EPI = false, bool SP2 = false, bool TA = true>
__device__ __forceinline__ void gemm_phase(PG8_LAS unsigned char* lds, const Gemm g, const Sched& S, const Epi& E) {
    const int tid = threadIdx.x, wid = __builtin_amdgcn_readfirstlane(tid >> 6), lane = tid & 63, wr = wid >> 2, wc = wid & 3, fr = lane & 15, fq = lane >> 4;
    const int K = g.K, nt = K / BK;
    unsigned voffA[2], voffB[2];
#pragma unroll
    for (int i = 0; i < 2; ++i) { int R, C; stage_rc(tid * 16 + i * 8192, R, C); const int Rb = Epi::PERM ? ((R & ~31) + perm32(R & 31)) : R;
        voffA[i] = TA ? (unsigned)(tid * 16 + i * 8192) : (unsigned)(R * K + C) * 2u; voffB[i] = (unsigned)(tid * 16 + i * 8192); (void)Rb; }
    const size_t kstep = TA ? (size_t)HTB : (size_t)(BK * 2);
    const size_t kstepB = (size_t)HTB;
    const size_t hstep = (size_t)HALF * K * 2;
    const size_t tstep = 2 * hstep;
    const unsigned ldsw = (unsigned)wid * 1024u;
    const int aoff = lds_byte(wr * 64 + fr, fq * 8), boff = lds_byte(wc * 32 + fr, fq * 8);
#define PG8_SA(b, h) (((b) * 2 + (h)) * HTB)
#define PG8_SB(b, h) ((4 + (b) * 2 + (h)) * HTB)
#define PG8_STAGE(bufoff, gbase, voff) do { _Pragma("unroll") for (int _i = 0; _i < 2; ++_i) \
        __builtin_amdgcn_global_load_lds((const unsigned*)((const char*)(gbase) + (voff)[_i]), (PG8_LAS unsigned*)(lds + (bufoff) + ldsw + _i * 8192), 16, 0, 0); } while (0)
#define PG8_LDA(dst, b, h) do { _Pragma("unroll") for (int m = 0; m < 4; ++m) _Pragma("unroll") for (int k = 0; k < 2; ++k) dst[m][k] = *(const PG8_LAS bf16x8*)(lds + PG8_SA(b, h) + aoff + m * 2048 + k * 1024); } while (0)
#define PG8_LDB(dst, b, h) do { _Pragma("unroll") for (int n = 0; n < 2; ++n) _Pragma("unroll") for (int k = 0; k < 2; ++k) dst[n][k] = *(const PG8_LAS bf16x8*)(lds + PG8_SB(b, h) + boff + n * 2048 + k * 1024); } while (0)
#define PG8_MMA(ai, bj, At, Bt) do { __builtin_amdgcn_s_setprio(1); _Pragma("unroll") for (int m = 0; m < 4; ++m) _Pragma("unroll") for (int n = 0; n < 2; ++n) _Pragma("unroll") for (int k = 0; k < 2; ++k) \
        acc[ai][bj][m][n] = __builtin_amdgcn_mfma_f32_16x16x32_bf16(Bt[n][k], At[m][k], acc[ai][bj][m][n], 0, 0, 0); __builtin_amdgcn_s_setprio(0); } while (0)
#define PG8_WAIT_V(n) asm volatile("s_waitcnt vmcnt(" #n ")" ::: "memory")
#define PG8_WAIT_L(n) asm volatile("s_waitcnt lgkmcnt(" #n ")" ::: "memory")
#define PG8_BAR __builtin_amdgcn_s_barrier()
#define PG8_SCHED __builtin_amdgcn_sched_barrier(0)
    Unit cur, nxt; int ui = 0;
    if (!S.next(0, cur)) return;
#define PG8_RTAB(u_, ui_) do { if constexpr (Epi::RSTD) { if (tid < 256) { const f32x4* p_ = (const f32x4*)(E.rstd_src() + (size_t)((u_).pm * BM + tid) * 16); const f32x4 s4_ = (p_[0] + p_[1]) + (p_[2] + p_[3]); \
        ((PG8_LAS float*)(lds + STAGE_BYTES + 1024 + ((ui_) & 1) * 1024))[tid] = __builtin_amdgcn_rsqf(((s4_[0] + s4_[1]) + (s4_[2] + s4_[3])) * (1.0f / 1024.0f) + 1e-6f); } } } while (0)
    PG8_RTAB(cur, 0);
    f32x4 acc[2][2][4][2];
#pragma unroll
    for (int a = 0; a < 2; ++a)
#pragma unroll
        for (int b = 0; b < 2; ++b)
#pragma unroll
            for (int m = 0; m < 4; ++m)
#pragma unroll
                for (int n = 0; n < 2; ++n) acc[a][b][m][n] = (f32x4){0.f, 0.f, 0.f, 0.f};
    bf16x8 At[4][2], B0[2][2], B1[2][2];
    const char* cA = (const char*)g.A + (size_t)cur.pm * tstep; const char* cB = (const char*)g.Bt + (size_t)cur.pn * tstep;
    S.a_ready(cur);
    if constexpr (SP2) {
        PG8_STAGE(PG8_SB(0, 0), cB, voffB); PG8_STAGE(PG8_SB(0, 1), cB + hstep, voffB); PG8_STAGE(PG8_SA(0, 0), cA, voffA); PG8_STAGE(PG8_SA(0, 1), cA + hstep, voffA);
        if (wr == 1) PG8_BAR;
        PG8_WAIT_V(2); PG8_BAR;
        PG8_STAGE(PG8_SB(1, 0), cB + kstepB, voffB); PG8_STAGE(PG8_SA(1, 0), cA + kstep, voffA); PG8_STAGE(PG8_SB(1, 1), cB + hstep + kstepB, voffB);
        PG8_WAIT_V(6); PG8_BAR;
    } else {
        PG8_STAGE(PG8_SB(0, 0), cB, voffB); PG8_STAGE(PG8_SA(0, 0), cA, voffA); PG8_STAGE(PG8_SB(0, 1), cB + hstep, voffB); PG8_STAGE(PG8_SA(0, 1), cA + hstep, voffA);
        if (wr == 1) PG8_BAR;
        PG8_WAIT_V(4); PG8_BAR;
        PG8_STAGE(PG8_SB(1, 0), cB + kstepB, voffB); PG8_STAGE(PG8_SA(1, 0), cA + kstep, voffA); PG8_STAGE(PG8_SB(1, 1), cB + hstep + kstepB, voffB);
        PG8_WAIT_V(6); PG8_BAR;
    }
    for (;;) {
        const bool has_next = S.next(ui + 1, nxt);
        const char* nA = has_next ? (const char*)g.A + (size_t)nxt.pm * tstep : cA; const char* nB = has_next ? (const char*)g.Bt + (size_t)nxt.pn * tstep : cB;
#pragma unroll 1
        for (int t = 0; t < nt; t += 2) {
            const bool last = (t == nt - 2);
            const char* a1 = cA + (size_t)(t + 1) * kstep;
            const char* a2 = last ? nA : cA + (size_t)(t + 2) * kstep; const char* b2 = last ? nB : cB + (size_t)(t + 2) * kstepB;
            const char* a3 = a2 + kstep; const char* b3 = b2 + kstepB;
            if (last && has_next) S.a_ready(nxt);
            if constexpr (SP2) {
            PG8_LDB(B0, 0, 0); PG8_LDB(B1, 0, 1); PG8_SCHED; PG8_LDA(At, 0, 0); PG8_STAGE(PG8_SA(1, 1), a1 + hstep, voffA);
            PG8_WAIT_V(8); PG8_WAIT_L(0); PG8_BAR; PG8_MMA(0, 0, At, B0); PG8_MMA(0, 1, At, B1); PG8_BAR; PG8_SCHED;
            PG8_LDA(At, 0, 1); PG8_STAGE(PG8_SB(0, 0), b2, voffB); PG8_STAGE(PG8_SB(0, 1), b2 + hstep, voffB); PG8_STAGE(PG8_SA(0, 0), a2, voffA);
            PG8_WAIT_V(8); PG8_WAIT_L(0); PG8_BAR; PG8_MMA(1, 0, At, B0); PG8_MMA(1, 1, At, B1); PG8_BAR; PG8_SCHED;
            PG8_LDB(B0, 1, 0); PG8_LDB(B1, 1, 1); PG8_SCHED; PG8_LDA(At, 1, 0); PG8_STAGE(PG8_SA(0, 1), a2 + hstep, voffA);
            PG8_WAIT_V(8); PG8_WAIT_L(0); PG8_BAR; PG8_MMA(0, 0, At, B0); PG8_MMA(0, 1, At, B1); PG8_BAR; PG8_SCHED;
            PG8_LDA(At, 1, 1); PG8_STAGE(PG8_SB(1, 0), b3, voffB); PG8_STAGE(PG8_SB(1, 1), b3 + hstep, voffB); PG8_STAGE(PG8_SA(1, 0), a3, voffA);
            PG8_WAIT_V(8); PG8_WAIT_L(0); PG8_BAR; PG8_MMA(1, 0, At, B0); PG8_MMA(1, 1, At, B1); PG8_BAR; PG8_SCHED;
            } else {
            PG8_LDB(B0, 0, 0); PG8_SCHED; PG8_LDA(At, 0, 0); PG8_STAGE(PG8_SA(1, 1), a1 + hstep, voffA);
            PG8_WAIT_L(8); PG8_BAR; PG8_WAIT_L(0); PG8_MMA(0, 0, At, B0); PG8_BAR; PG8_SCHED;
            PG8_LDB(B1, 0, 1); PG8_STAGE(PG8_SB(0, 0), b2, voffB);
            PG8_BAR; PG8_WAIT_L(0); PG8_MMA(0, 1, At, B1); PG8_BAR;
            PG8_LDA(At, 0, 1); PG8_STAGE(PG8_SA(0, 0), a2, voffA);
            PG8_BAR; PG8_WAIT_L(0); PG8_MMA(1, 0, At, B0); PG8_BAR; PG8_SCHED;
            PG8_STAGE(PG8_SB(0, 1), b2 + hstep, voffB);
            PG8_WAIT_V(6); PG8_BAR; PG8_MMA(1, 1, At, B1); PG8_BAR;
            PG8_LDB(B0, 1, 0); PG8_SCHED; PG8_LDA(At, 1, 0); PG8_STAGE(PG8_SA(0, 1), a2 + hstep, voffA);
            PG8_WAIT_L(8); PG8_BAR; PG8_WAIT_L(0); PG8_MMA(0, 0, At, B0); PG8_BAR; PG8_SCHED;
            PG8_LDB(B1, 1, 1); PG8_STAGE(PG8_SB(1, 0), b3, voffB);
            PG8_BAR; PG8_WAIT_L(0); PG8_MMA(0, 1, At, B1); PG8_BAR;
            PG8_LDA(At, 1, 1); PG8_STAGE(PG8_SA(1, 0), a3, voffA);
            PG8_BAR; PG8_WAIT_L(0); PG8_MMA(1, 0, At, B0); PG8_BAR; PG8_SCHED;
            PG8_STAGE(PG8_SB(1, 1), b3 + hstep, voffB);
            PG8_WAIT_V(6); PG8_BAR; PG8_MMA(1, 1, At, B1); PG8_BAR;
            }
        }
        if constexpr (ALIGN_EPI) { if (wr == 0) PG8_BAR; }
        if constexpr (!Epi::AFTER_DRAIN) { E(acc, cur, wr, wc, fr, fq, (const PG8_LAS float*)(lds + STAGE_BYTES + 1024 + (ui & 1) * 1024)); S.done(cur); }
        if (!has_next) break;
#pragma unroll
        for (int a = 0; a < 2; ++a)
#pragma unroll
            for (int b = 0; b < 2; ++b)
#pragma unroll
                for (int m = 0; m < 4; ++m)
#pragma unroll
                    for (int n = 0; n < 2; ++n) acc[a][b][m][n] = (f32x4){0.f, 0.f, 0.f, 0.f};
        cur = nxt; cA = nA; cB = nB; ++ui;
        PG8_RTAB(cur, ui);
        if constexpr (ALIGN_EPI) { if (wr == 1) PG8_BAR; }
    }
    PG8_WAIT_V(0);
    if constexpr (!ALIGN_EPI) { if (wr == 0) PG8_BAR; }
    PG8_BAR;
    if constexpr (Epi::AFTER_DRAIN) { E.fused(acc, cur, wr, wc, fr, fq, lds, wid, lane); S.done(cur); }
#undef PG8_RTAB
#undef PG8_SA
#undef PG8_SB
#undef PG8_STAGE
#undef PG8_LDA
#undef PG8_LDB
#undef PG8_MMA
#undef PG8_WAIT_V
#undef PG8_WAIT_L
#undef PG8_BAR
#undef PG8_SCHED
}
}

#ifndef PG8_SP2
#define PG8_SP2 true
#endif
#ifndef PG8_ALIGN
#define PG8_ALIGN true
#endif
#include <hip/hip_bf16.h>
#include <cmath>
namespace attn_body {
using bf16=__hip_bfloat16;
using bf16x8=__attribute__((ext_vector_type(8)))short;
using s16x4=__attribute__((ext_vector_type(4)))short;
using f32x16=__attribute__((ext_vector_type(16)))float;
using u32x4=__attribute__((ext_vector_type(4)))unsigned;
constexpr int BATCH=4,NHEAD=16,SEQ=8192,D=64,DM=NHEAD*D;
constexpr int NW=8,QBLK=32,QB=QBLK*NW,KVBLK=64,NQB=SEQ/QB;
constexpr int ATTN_PITCH=DM, ATTN_UNIT_ROWS=QB;
__device__ __forceinline__ int crow(int r,int hi){return (r&3)+8*(r>>2)+4*hi;}
#define SBAR() __builtin_amdgcn_sched_barrier(0)
typedef __attribute__((address_space(3))) const float* lds_cfptr;
__device__ __forceinline__ void cmask(f32x16&p0,f32x16&p1,int jb,int qrel,int hi,lds_cfptr bt){
  const lds_cfptr t=bt+(qrel-64*jb-4*hi+256);
  const int dq=qrel-64*jb-4*hi;
  #pragma unroll
  for(int r=0;r<16;++r){const int off=(r&3)+8*(r>>2); const float b0=t[-off],b1=t[-off-32]; p0[r]=(dq-off<0)?-INFINITY:p0[r]+b0; p1[r]=(dq-off-32<0)?-INFINITY:p1[r]+b1;}
}

constexpr int NSLOT=3, SLOTB=8192;
constexpr int LDS_K=0, LDS_V=NSLOT*SLOTB, LDS_WS=3*NSLOT*SLOTB, LDS_OST=LDS_WS+NW*64*4, LDS_BIAS=LDS_OST+NW*4096, LDS_BYTES=LDS_BIAS+4096;
constexpr float C2=0.125f*1.4426950408889634f;
__device__ __forceinline__ void glds16(const void*gsrc,unsigned lds_dst){unsigned keep;
  asm volatile("s_mov_b32 %0, m0\n\ts_mov_b32 m0, %2\n\ts_nop 0\n\tglobal_load_lds_dwordx4 %1, off\n\ts_mov_b32 m0, %0":"=&s"(keep):"v"(gsrc),"s"(lds_dst):"memory");}
__device__ __forceinline__ float max3f(float a,float b,float c){float r;asm("v_max3_f32 %0, %1, %2, %3":"=v"(r):"v"(a),"v"(b),"v"(c));return r;}
__device__ __forceinline__ float max2f(float a,float b){float r;asm("v_max_f32_e32 %0, %1, %2":"=v"(r):"v"(a),"v"(b));return r;}
__device__ __forceinline__ float fadd_s(float a,float b){float r;asm("v_add_f32_e32 %0, %1, %2":"=v"(r):"v"(a),"v"(b));return r;}
__device__ __forceinline__ float fsub_s(float a,float b){float r;asm("v_sub_f32_e32 %0, %1, %2":"=v"(r):"v"(a),"v"(b));return r;}
typedef float f32x2_t __attribute__((ext_vector_type(2))); typedef __bf16 bf16x2_t __attribute__((ext_vector_type(2)));
__device__ __forceinline__ unsigned cvtpk_s(float lo,float hi){f32x2_t v={lo,hi};bf16x2_t b=__builtin_convertvector(v,bf16x2_t);return __builtin_bit_cast(unsigned,b);}
#define WAIT_BAR(N) asm volatile("s_waitcnt vmcnt(" #N ") lgkmcnt(0)\n\ts_barrier":::"memory")

__device__ __forceinline__ void qkt(f32x16&p0,f32x16&p1,const char*Kslot,const bf16x8*qr,const f32x16&negm,int r32,int hi){
  const char*kb=Kslot+hi*1024+r32*16;
  #pragma unroll
  for(int d0=0;d0<4;++d0){
    const bf16x8 b0=*reinterpret_cast<const bf16x8*>(kb+d0*2048);
    const bf16x8 b1=*reinterpret_cast<const bf16x8*>(kb+d0*2048+512);
    if(d0==0){p0=__builtin_amdgcn_mfma_f32_32x32x16_bf16(b0,qr[0],negm,0,0,0);p1=__builtin_amdgcn_mfma_f32_32x32x16_bf16(b1,qr[0],negm,0,0,0);}
    else{p0=__builtin_amdgcn_mfma_f32_32x32x16_bf16(b0,qr[d0],p0,0,0,0);p1=__builtin_amdgcn_mfma_f32_32x32x16_bf16(b1,qr[d0],p1,0,0,0);}}
}
typedef __attribute__((address_space(3))) const char* lds_cptr;
typedef short v4i16_t __attribute__((ext_vector_type(4)));
__device__ __forceinline__ void kload8(bf16x8*kf,lds_cptr kp){
  kf[0]=*(const __attribute__((address_space(3))) bf16x8*)(kp);      kf[1]=*(const __attribute__((address_space(3))) bf16x8*)(kp+512);
  kf[2]=*(const __attribute__((address_space(3))) bf16x8*)(kp+2048); kf[3]=*(const __attribute__((address_space(3))) bf16x8*)(kp+2560);
  kf[4]=*(const __attribute__((address_space(3))) bf16x8*)(kp+4096); kf[5]=*(const __attribute__((address_space(3))) bf16x8*)(kp+4608);
  kf[6]=*(const __attribute__((address_space(3))) bf16x8*)(kp+6144); kf[7]=*(const __attribute__((address_space(3))) bf16x8*)(kp+6656);
}
__device__ __forceinline__ void kload2(bf16x8*kf,lds_cptr kp,int j){ kf[2*j]=*(const __attribute__((address_space(3))) bf16x8*)(kp+j*2048); kf[2*j+1]=*(const __attribute__((address_space(3))) bf16x8*)(kp+j*2048+512); }
__device__ __forceinline__ s16x4 vtr(lds_cptr p){ return __builtin_bit_cast(s16x4,__builtin_amdgcn_ds_read_tr16_b64_v4i16((__attribute__((address_space(3))) v4i16_t*)p)); }
__device__ __forceinline__ float rowmax(const f32x16&p0,const f32x16&p1){
  float a=max3f(p0[0],p0[1],p1[0]),b=max3f(p0[2],p0[3],p1[1]);a=max3f(a,p1[2],p1[3]);
  #pragma unroll
  for(int r=4;r<16;r+=4){a=max3f(a,p0[r],p0[r+1]);b=max3f(b,p0[r+2],p0[r+3]);a=max3f(a,p1[r],p1[r+1]);b=max3f(b,p1[r+2],p1[r+3]);}
  const float m=max2f(a,b);
  auto rr=__builtin_amdgcn_permlane32_swap(__float_as_uint(m),__float_as_uint(m),false,false);
  return max2f(__uint_as_float(rr[0]),__uint_as_float(rr[1]));
}
__device__ __forceinline__ void pv(f32x16*o,int vb,bf16x8 pa0,bf16x8 pa1,bf16x8 pa2,bf16x8 pa3){
  #pragma unroll
  for(int d0=0;d0<4;++d0){s16x4 lo[4],hi[4];
    #pragma unroll
    for(int ks=0;ks<4;++ks){
      asm volatile("ds_read_b64_tr_b16 %0,%1 offset:%c2":"=&v"(lo[ks]):"v"(vb),"i"(d0*4096+ks*1024):"memory");
      asm volatile("ds_read_b64_tr_b16 %0,%1 offset:%c2":"=&v"(hi[ks]):"v"(vb),"i"(d0*4096+ks*1024+512):"memory");}
    asm volatile("s_waitcnt lgkmcnt(0)":::"memory");SBAR();
    #define PK(k) (bf16x8){lo[k][0],lo[k][1],lo[k][2],lo[k][3],hi[k][0],hi[k][1],hi[k][2],hi[k][3]}
    o[d0]=__builtin_amdgcn_mfma_f32_32x32x16_bf16(pa0,PK(0),o[d0],0,0,0);
    o[d0]=__builtin_amdgcn_mfma_f32_32x32x16_bf16(pa1,PK(1),o[d0],0,0,0);
    o[d0]=__builtin_amdgcn_mfma_f32_32x32x16_bf16(pa2,PK(2),o[d0],0,0,0);
    o[d0]=__builtin_amdgcn_mfma_f32_32x32x16_bf16(pa3,PK(3),o[d0],0,0,0);
    #undef PK
  }
}

#ifndef ATTN_STORE16
#define ATTN_STORE16(p,v) (*(u32x4*)(p)=(v))
#endif
template<int THRL> __device__ __forceinline__ void attn_unit(int b,int hc,int qb,const bf16*Q,const bf16*__restrict__ K,const bf16*__restrict__ V,bf16*O,char*shm){
  const int tid=threadIdx.x,lane=tid&63,r32=lane&31,hi=lane>>5; const int wid=__builtin_amdgcn_readfirstlane(tid>>6);
  const long rowbase=(long)b*SEQ; const int q0=qb*QB;
  const bf16*Qw=Q+(rowbase+q0+wid*QBLK)*DM+hc*D;
  const lds_cfptr btab=(lds_cfptr)((lds_cptr)shm+LDS_BIAS);
  const unsigned lds0=(unsigned)(uintptr_t)shm;
  float*wsf=(float*)(shm+LDS_WS)+wid*64;
  const bf16*ksrc=K+(long)((b*16+hc)*128)*4096+wid*512+lane*8;
  const bf16*vsrc=V+(long)((b*8+(hc>>1))*128)*8192+wid*512+lane*8;
  const unsigned kdst=lds0+LDS_K+wid*1024, vdst=lds0+LDS_V+wid*1024;
  #define DMA_K(t,slot) glds16(ksrc+(long)(t)*4096,(unsigned)__builtin_amdgcn_readfirstlane(kdst+(slot)))
  #define DMA_V(t,slot) do{ glds16(vsrc+(long)(t)*8192,(unsigned)__builtin_amdgcn_readfirstlane(vdst+2*(slot))); glds16(vsrc+(long)(t)*8192+4096,(unsigned)__builtin_amdgcn_readfirstlane(vdst+2*(slot)+8192)); }while(0)
  const int vb0=(int)(lds0+LDS_V)+((lane>>4)&1)*32+(lane&3)*8+(4*hi+((lane&15)>>2))*64;
  const char*Kbase=shm+LDS_K; bf16x8 kf[8];
  const lds_cptr shm3=(lds_cptr)shm; const lds_cptr kp0=shm3+LDS_K+hi*1024+r32*16; const lds_cptr vp0=shm3+LDS_V+((lane>>4)&1)*32+(lane&3)*8+(4*hi+((lane&15)>>2))*64;
  const int NT=(q0+QB)/KVBLK;
  DMA_K(0,0);DMA_V(0,0);DMA_K(1,SLOTB);
  bf16x8 qr[4];
  #pragma unroll
  for(int d0=0;d0<4;++d0)qr[d0]=*reinterpret_cast<const bf16x8*>(&Qw[(long)r32*DM+d0*16+hi*8]);
  float mhat=0.f,l_reg=0.f;f32x16 o[4];o[0]=f32x16{};o[1]=f32x16{};o[2]=f32x16{};o[3]=f32x16{};
  const f32x16 zero16=f32x16{};
  const int qrel=wid*QBLK+r32;
  #define CMASK(P0,P1,t) do{int jb_=(t)-(NT-4); if(jb_>=-2&&(32*wid-64*jb_<176||64*jb_+63>32*wid))cmask(P0,P1,jb_,qrel,hi,btab);}while(0)
  bool resc=false;
  #define RESC() do{ if(resc){ asm volatile("s_waitcnt lgkmcnt(0)":::"memory"); \
      _Pragma("unroll") for(int d_=0;d_<4;++d_) _Pragma("unroll") for(int r=0;r<16;++r)o[d_][r]*=wsf[crow(r,hi)]; } }while(0)
  f32x16 pA0,pA1,pB0,pB1;
  int sl_prev=0,sl_cur=0,sl_next=SLOTB;
  #define ROT() do{sl_prev=sl_cur;sl_cur=sl_next;sl_next=(sl_next==(NSLOT-1)*SLOTB)?0:sl_next+SLOTB;}while(0)
  DMA_K(2,2*SLOTB);
  WAIT_BAR(4);
  qkt(pA0,pA1,Kbase,qr,zero16,r32,hi);asm volatile("s_nop 15\n\ts_nop 7":"+v"(pA0),"+v"(pA1));CMASK(pA0,pA1,0);
  { const float rm=rowmax(pA0,pA1); mhat=rm;
    _Pragma("unroll") for(int r=0;r<16;++r){pA0[r]=__builtin_amdgcn_exp2f(pA0[r]-mhat);pA1[r]=__builtin_amdgcn_exp2f(pA1[r]-mhat);} }
  WAIT_BAR(0);
  DMA_K(3,0);DMA_V(1,SLOTB);
  ROT();
  kload8(kf,kp0+sl_cur);
  WAIT_BAR(3);
  s16x4 vl[16],vh[16]; u32x4 pw0,pw1,pw2,pw3;
  #define PKW(P,B) cvtpk_s(P[B],P[B+1])
  #define PAF(k) __builtin_bit_cast(bf16x8,pw##k)
  #define VFR(i) (bf16x8){vl[i][0],vl[i][1],vl[i][2],vl[i][3],vh[i][0],vh[i][1],vh[i][2],vh[i][3]}
  #define PIN(x) asm volatile("":"+v"(x))
  #define MX3(a,b,c) __builtin_fmaxf(__builtin_fmaxf((a),(b)),(c))
  #define GAPA(MF,A0,A1,A2,A3,W0,W1,PW) do{ MF; sacc+=A0; sacc+=A1; sacc+=A2; sacc+=A3; PIN(sacc); W0; W1; PIN(PW); SBAR(); }while(0)
  #define EX(v) __builtin_amdgcn_exp2f(v)
  #define GAPB(MF,X,B,PN,BN) do{ MF; X[B]=EX(X[B]); X[B+1]=EX(X[B+1]); PIN(X); SBAR(); }while(0)
  #define VRL(j) do{ vl[j]=vtr(vp_+(((j)&3)*4096+((j)>>2)*1024)); }while(0)
  #define VRH(j) do{ vh[j]=vtr(vp_+(((j)&3)*4096+((j)>>2)*1024+512)); }while(0)
  #define VR(j) do{ VRL(j); VRH(j); SBAR(); }while(0)
  #define KRD(G,j) do{ if(G){ kload2(kf,kp0+sl_next,j); SBAR(); } }while(0)
  #define PVJ(ks,dq,j) o[dq]=__builtin_amdgcn_mfma_f32_32x32x16_bf16(PAF(ks),VFR(j),o[dq],0,0,0)
  #define STEP(C0,C1,P0,P1,t,GK,GV,GL) do{ SBAR(); \
    const lds_cptr vp_=vp0+2*sl_prev; \
    { const float nm_=-mhat; _Pragma("unroll") for(int r=0;r<16;++r){C0[r]=nm_;C1[r]=nm_;} }   \
    VRL(0); SBAR(); float sacc=(P0[0]+P0[1]); \
    GAPA(C0=__builtin_amdgcn_mfma_f32_32x32x16_bf16(kf[0],qr[0],C0,0,0,0), P0[2],P0[3],P0[4],P0[5],     pw0[0]=PKW(P0,0), pw0[1]=PKW(P0,2), pw0); \
    VRH(0); SBAR(); GAPA(C1=__builtin_amdgcn_mfma_f32_32x32x16_bf16(kf[1],qr[0],C1,0,0,0), P0[6],P0[7],P0[8],P0[9],     pw0[2]=PKW(P0,4), pw0[3]=PKW(P0,6), pw0); \
    VRL(1); SBAR(); GAPA(C0=__builtin_amdgcn_mfma_f32_32x32x16_bf16(kf[2],qr[1],C0,0,0,0),   P0[10],P0[11],P0[12],P0[13], pw1[0]=PKW(P0,8), pw1[1]=PKW(P0,10), pw1); \
    VRH(1); SBAR(); GAPA(C1=__builtin_amdgcn_mfma_f32_32x32x16_bf16(kf[3],qr[1],C1,0,0,0),   P0[14],P0[15],P1[0],P1[1],   pw1[2]=PKW(P0,12),pw1[3]=PKW(P0,14), pw1); \
    VRL(2); SBAR(); GAPA(C0=__builtin_amdgcn_mfma_f32_32x32x16_bf16(kf[4],qr[2],C0,0,0,0),   P1[2],P1[3],P1[4],P1[5],     pw2[0]=PKW(P1,0), pw2[1]=PKW(P1,2), pw2); \
    VRH(2); SBAR(); GAPA(C1=__builtin_amdgcn_mfma_f32_32x32x16_bf16(kf[5],qr[2],C1,0,0,0),   P1[6],P1[7],P1[8],P1[9],     pw2[2]=PKW(P1,4), pw2[3]=PKW(P1,6), pw2); \
    VRL(3); SBAR(); GAPA(C0=__builtin_amdgcn_mfma_f32_32x32x16_bf16(kf[6],qr[3],C0,0,0,0),   P1[10],P1[11],P1[12],P1[13], pw3[0]=PKW(P1,8), pw3[1]=PKW(P1,10), pw3); \
    VRH(3); SBAR(); GAPA(C1=__builtin_amdgcn_mfma_f32_32x32x16_bf16(kf[7],qr[3],C1,0,0,0),   P1[14],P1[15],0.f,0.f,       pw3[2]=PKW(P1,12),pw3[3]=PKW(P1,14), pw3); \
    l_reg+=sacc; \
    if(GK){DMA_K((t)+3,sl_cur);} if(GV){DMA_V((t)+1,sl_next);} \
    CMASK(C0,C1,t); \
    { float a=MX3(C0[0],C0[1],C1[0]),b=MX3(C0[2],C0[3],C1[1]); a=MX3(a,C1[2],C1[3]); \
      _Pragma("unroll") for(int r=4;r<16;r+=4){a=MX3(a,C0[r],C0[r+1]);b=MX3(b,C0[r+2],C0[r+3]);a=MX3(a,C1[r],C1[r+1]);b=MX3(b,C1[r+2],C1[r+3]);} \
      float rm=__builtin_fmaxf(a,b); { auto rr=__builtin_amdgcn_permlane32_swap(__float_as_uint(rm),__float_as_uint(rm),false,false); rm=__builtin_fmaxf(__uint_as_float(rr[0]),__uint_as_float(rr[1])); } \
      resc=false; \
      if(__builtin_expect(__any(rm>(float)THRL),0)){ const float dl=__builtin_fmaxf(rm,0.f); mhat+=dl; \
        _Pragma("unroll") for(int r=0;r<16;++r){C0[r]-=dl;C1[r]-=dl;} \
        const float f=__builtin_amdgcn_exp2f(-dl); l_reg*=f; if(hi==0)wsf[r32]=f; resc=true; } } \
    SBAR(); \
    VR(4);  GAPB(PVJ(0,0,0),  C0,0,  P0,0); \
    VR(5);  GAPB(PVJ(0,1,1),  C0,2,  P0,2); \
    VR(6);  GAPB(PVJ(0,2,2),  C0,4,  P0,4); \
    VR(7);  GAPB(PVJ(0,3,3),  C0,6,  P0,6); \
    VR(8);  GAPB(PVJ(1,0,4),  C0,8,  P0,8); \
    VR(9);  GAPB(PVJ(1,1,5),  C0,10, P0,10); \
    VR(10); GAPB(PVJ(1,2,6),  C0,12, P0,12); \
    VR(11); GAPB(PVJ(1,3,7),  C0,14, P0,14); \
    VR(12); GAPB(PVJ(2,0,8),  C1,0,  P1,0); \
    VR(13); GAPB(PVJ(2,1,9),  C1,2,  P1,2); \
    VR(14); GAPB(PVJ(2,2,10), C1,4,  P1,4); \
    VR(15); GAPB(PVJ(2,3,11), C1,6,  P1,6); \
    KRD(GL,0); GAPB(PVJ(3,0,12), C1,8,  P1,8); \
    KRD(GL,1); GAPB(PVJ(3,1,13), C1,10, P1,10); \
    KRD(GL,2); GAPB(PVJ(3,2,14), C1,12, P1,12); \
    KRD(GL,3); GAPB(PVJ(3,3,15), C1,14, P1,14); \
    }while(0)
  int t=1;
  #undef CMASK
  #define CMASK(P0,P1,t) do{}while(0)
  for(;t+7<NT;t+=2){
    STEP(pB0,pB1,pA0,pA1,t,true,true,true);     WAIT_BAR(3); RESC(); ROT();
    STEP(pA0,pA1,pB0,pB1,t+1,true,true,true);   WAIT_BAR(3); RESC(); ROT();
  }
  #undef CMASK
  #define CMASK(P0,P1,t) do{int jb_=(t)-(NT-4); if(jb_>=-2&&(32*wid-64*jb_<176||64*jb_+63>32*wid))cmask(P0,P1,jb_,qrel,hi,btab);}while(0)
  #define ENDW(tt) do{ if((tt)+3<NT){WAIT_BAR(3);} else if((tt)+2<NT){WAIT_BAR(2);} else {WAIT_BAR(0);} }while(0)
  for(;t+1<NT;t+=2){
    STEP(pB0,pB1,pA0,pA1,t,(t+3<NT),(t+1<NT),(t+1<NT));       ENDW(t);   RESC(); ROT();
    STEP(pA0,pA1,pB0,pB1,t+1,(t+4<NT),(t+2<NT),(t+2<NT));     ENDW(t+1); RESC(); ROT();
  }
  STEP(pB0,pB1,pA0,pA1,NT-1,false,false,false); RESC();
  { float sacc=pB0[0]+pB0[1]; _Pragma("unroll") for(int r=2;r<16;++r)sacc+=pB0[r]; _Pragma("unroll") for(int r=0;r<16;++r)sacc+=pB1[r]; l_reg+=sacc;
    pw0=(u32x4){PKW(pB0,0),PKW(pB0,2),PKW(pB0,4),PKW(pB0,6)};pw1=(u32x4){PKW(pB0,8),PKW(pB0,10),PKW(pB0,12),PKW(pB0,14)};pw2=(u32x4){PKW(pB1,0),PKW(pB1,2),PKW(pB1,4),PKW(pB1,6)};pw3=(u32x4){PKW(pB1,8),PKW(pB1,10),PKW(pB1,12),PKW(pB1,14)};
    SBAR(); pv(o,vb0+2*sl_cur,PAF(0),PAF(1),PAF(2),PAF(3)); }
  #undef PKW
  #undef PAF
  #undef VFR
  #undef PIN
  #undef MX3
  #undef GAPA
  #undef GAPB
  #undef EX
  #undef VRL
  #undef VRH
  #undef VR
  #undef KRD
  #undef PVJ
  #undef STEP
  #undef ENDW
  {auto rr=__builtin_amdgcn_permlane32_swap(__float_as_uint(l_reg),__float_as_uint(l_reg),false,false);l_reg=__uint_as_float(rr[0])+__uint_as_float(rr[1]);}
  if(hi==0)wsf[32+r32]=l_reg;asm volatile("s_waitcnt lgkmcnt(0)":::"memory");
  float rli[16];
  #pragma unroll
  for(int r=0;r<16;++r)rli[r]=__builtin_amdgcn_rcpf(wsf[32+crow(r,hi)]);
  { bf16*stg=(bf16*)(shm+LDS_OST)+wid*2048;
    #pragma unroll
    for(int hp=0;hp<2;++hp){
      #pragma unroll
      for(int r=0;r<16;++r){const int orow=crow(r,hi);
        #pragma unroll
        for(int d0=0;d0<2;++d0)stg[orow*64+d0*32+r32]=__float2bfloat16(o[2*hp+d0][r]*rli[r]);}
      asm volatile("s_waitcnt lgkmcnt(0)":::"memory");
      #pragma unroll
      for(int i=0;i<4;++i){const int row=i*8+(lane>>3),ch=lane&7; const u32x4 v=*(const u32x4*)(stg+row*64+ch*8); ATTN_STORE16(O+pg8::tiled_off((int)(rowbase+q0+wid*QBLK)+row,(hc>>1)*128+hp*64+ch*8,DM),v);}
      asm volatile("s_waitcnt lgkmcnt(0)":::"memory"); } }
  asm volatile("s_waitcnt lgkmcnt(0)\n\ts_barrier":::"memory");
  #undef DMA_K
  #undef DMA_V
  #undef CMASK
  #undef RESC
  #undef ROT
}
constexpr int ATTN_LDS_BYTES=LDS_BYTES;
struct AttnTensors { const bf16* Q; const bf16* K; const bf16* V; bf16* O0; bf16* O1; };
struct AttnUnit { int bh; int qb; };
struct StaticOrder {
  int vcu;
  __device__ __forceinline__ explicit StaticOrder(int grid,int block):vcu((block%8)*(grid/8)+block/8){}
  __device__ __forceinline__ bool next(int i,AttnUnit&u)const{ if(i>=8)return false; const int s=vcu&7,k=i&3; { const int p_=vcu>>3; u.bh=(p_>>3)*16+(p_&7)*2+(i>>2); } u.qb=(k==0)?s:(k==1)?15-s:(k==2)?16+s:31-s; return true; }
  __device__ __forceinline__ void a_ready(const AttnUnit&)const{}
  __device__ __forceinline__ void done(const AttnUnit&)const{}
};
template<class Sched,int THRL=8> __device__ __forceinline__ void attn_phase(char*lds,const AttnTensors&T,const Sched&S){
  AttnUnit u;
  for(int i=0;S.next(i,u);++i){ S.a_ready(u); { const int hc_=u.bh&15; attn_unit<THRL>(u.bh>>4,hc_,u.qb,T.Q,T.K,T.V,(hc_&1)?T.O1:T.O0,lds); } S.done(u); }
}
#undef SBAR
#undef WAIT_BAR
}
namespace cg = cooperative_groups;
constexpr int NWAVES = 8;
constexpr int BATCH = 4, SEQ = 8192, D = 1024, M = BATCH * SEQ, DFF = 2816, PLE = 256, CW = 31;
constexpr size_t MiB = 1u << 20;
constexpr size_t WS_CTL = 0, WS_BT = 1 * MiB  , WS_SSA = 2 * MiB, WS_SSB = 4 * MiB;
constexpr size_t WS_WPW1 = 8 * MiB, WS_WPW2 = 12 * MiB, WS_WQKV = 14 * MiB, WS_WO = 20 * MiB, WS_WGU0 = 22 * MiB, WS_WGU1 = 33 * MiB, WS_WD0 = 44 * MiB, WS_WD1 = 50 * MiB,
                 WS_WPG0 = 56 * MiB, WS_WPG1 = 58 * MiB, WS_WPP0 = 60 * MiB, WS_WPP1 = 61 * MiB;
constexpr size_t WS_PB = 64 * MiB  , WS_HBA = 96 * MiB, WS_HBB = 160 * MiB, WS_F = 224 * MiB  ;
constexpr size_t WS_U = 224 * MiB, WS_V2 = 288 * MiB, WS_Q = 224 * MiB, WS_K = 288 * MiB, WS_V = 352 * MiB, WS_PP = 416 * MiB, WS_O1 = 416 * MiB, WS_END = 480 * MiB;
static_assert(WS_F + (size_t)M * DFF * 2 <= WS_PP && WS_V + (size_t)M * D * 2 <= WS_PP, "ws map");
constexpr int RING_BYTES = 131072, LDS_TOTAL = 147456;
#define GAS __attribute__((address_space(1)))
#define LAS __attribute__((address_space(3)))
typedef unsigned short bf16;
typedef unsigned v4u __attribute__((ext_vector_type(4)));
typedef float f32x4 __attribute__((ext_vector_type(4)));
#define LDS_WAIT() asm volatile("s_waitcnt lgkmcnt(0)" ::: "memory")
__device__ __forceinline__ unsigned f2bf(float f) { unsigned u = __builtin_bit_cast(unsigned, f); return (u + 0x7fffu + ((u >> 16) & 1u)) >> 16; }
__device__ __forceinline__ unsigned pk2(float lo, float hi) { return f2bf(lo) | (f2bf(hi) << 16); }
__device__ __forceinline__ float wave_sum(float v) {
#pragma unroll
    for (int o = 1; o < 64; o <<= 1) v += __shfl_xor(v, o);
    return v;
}
#define XB_TMO      128
#define XB_XCNT(j)  (256  + 64 * (j))
#define XB_XSUB(j)  (1280 + 64 * (j))
#define XB_XGEN(j)  (2304 + 64 * (j))
#define XB_TOP      3328
#define XB_TOPGEN   3392
#define XCD_BAR_WORDS 3456
#define XB_SPIN_CAP (1u << 18)

__device__ __forceinline__ unsigned xb_ld(unsigned* p)              { return __hip_atomic_load(p, __ATOMIC_RELAXED, __HIP_MEMORY_SCOPE_AGENT); }
__device__ __forceinline__ unsigned xb_add(unsigned* p, unsigned v) { return __hip_atomic_fetch_add(p, v, __ATOMIC_RELAXED, __HIP_MEMORY_SCOPE_AGENT); }
__device__ __forceinline__ unsigned xb_xcc_id() { return (unsigned)__builtin_amdgcn_s_getreg((3 << 11) | 20) & 0xFu; }
#define XB_SPIN(cond, bar) do { unsigned _sp = 0; while (cond) { __builtin_amdgcn_s_sleep(1); \
    if ((++_sp & 255u) == 0u) { if (xb_ld(&(bar)[XB_TMO])) break; if (_sp > XB_SPIN_CAP) { atomicAdd(&(bar)[XB_TMO], 1u); break; } } } } while (0)

struct XcdBarrier {
    unsigned* bar; unsigned x;
    volatile LAS unsigned* st;
};

__device__ __forceinline__ XcdBarrier xcd_barrier_post(unsigned* bar, volatile LAS unsigned* st) {
    XcdBarrier b; b.bar = bar; b.x = xb_xcc_id(); b.st = st;
    if (threadIdx.x == 0) (void)xb_add(&bar[XB_XCNT(b.x)], 1u);
    return b;
}
__device__ __forceinline__ void xcd_barrier_complete(unsigned* bar, unsigned x, unsigned& nloc, unsigned& nx) {
    const unsigned G = gridDim.x * gridDim.y * gridDim.z;
    unsigned sum, cnt, mine, sp = 0u;
    for (;;) {
        sum = 0u; cnt = 0u; mine = 0u;
#pragma unroll
        for (unsigned j = 0; j < 16; ++j) { const unsigned c = xb_ld(&bar[XB_XCNT(j)]); sum += c; cnt += (c > 0u) ? 1u : 0u; mine = (j == x) ? c : mine; }
        if (sum == G) break;
        __builtin_amdgcn_s_sleep(1);
        if ((++sp & 255u) == 0u) { if (xb_ld(&bar[XB_TMO])) break; if (sp > XB_SPIN_CAP) { atomicAdd(&bar[XB_TMO], 1u); break; } }
    }
    nloc = mine > 0u ? mine : 1u; nx = cnt > 0u ? cnt : 1u;
}

__device__ __forceinline__ void xcd_barrier(const XcdBarrier& b) {
    asm volatile("s_waitcnt vmcnt(0)" ::: "memory");
    __syncthreads();
    if (threadIdx.x == 0) {
        unsigned* bar = b.bar;
        __builtin_amdgcn_s_waitcnt(0);
        unsigned nloc = b.st[0], nx = b.st[1];
        if (nloc == 0u) { xcd_barrier_complete(bar, b.x, nloc, nx); b.st[0] = nloc; b.st[1] = nx; }
        const unsigned old = xb_add(&bar[XB_XSUB(b.x)], 1u);
        const unsigned gen = old / nloc;
        if (old + 1u == (gen + 1u) * nloc) {
            __builtin_amdgcn_fence(__ATOMIC_RELEASE, "agent");
            asm volatile("s_waitcnt vmcnt(0)" ::: "memory");
            const unsigned og = xb_add(&bar[XB_TOP], 1u);
            const unsigned tg = og / nx;
            if (og + 1u == (tg + 1u) * nx) xb_add(&bar[XB_TOPGEN], 1u);
            else XB_SPIN(xb_ld(&bar[XB_TOPGEN]) == tg, bar);
            __builtin_amdgcn_fence(__ATOMIC_ACQUIRE, "agent");
            xb_add(&bar[XB_XGEN(b.x)], 1u);
            asm volatile("s_waitcnt vmcnt(0)" ::: "memory");
        } else {
            XB_SPIN(xb_ld(&bar[XB_XGEN(b.x)]) == gen, bar);
            __builtin_amdgcn_fence(__ATOMIC_ACQUIRE, "agent");
            asm volatile("s_waitcnt vmcnt(0)" ::: "memory");
        }
    }
    __syncthreads();
}

__device__ const unsigned char T5_BUCKET[128] = {0, 1, 2, 3, 4, 5, 6, 7, 8, 9, 10, 11, 12, 13, 14, 15, 16, 16, 16, 17, 17, 18, 18, 18, 19, 19, 19, 20, 20, 20, 20, 21, 21, 21, 21, 22, 22, 22, 22, 22, 23, 23, 23, 23, 23, 23, 24, 24, 24, 24, 24, 24, 25, 25, 25, 25, 25, 25, 25, 26, 26, 26, 26, 26, 26, 26, 26, 27, 27, 27, 27, 27, 27, 27, 27, 27, 27, 28, 28, 28, 28, 28, 28, 28, 28, 28, 28, 29, 29, 29, 29, 29, 29, 29, 29, 29, 29, 29, 29, 30, 30, 30, 30, 30, 30, 30, 30, 30, 30, 30, 30, 30, 30, 31, 31, 31, 31, 31, 31, 31, 31, 31, 31, 31, 31, 31, 31, 31};

struct Args { const float* in[29]; float* out; unsigned char* ws; int ph_lo, ph_hi; };
enum { I_X = 0, I_P, I_CNG, I_CW1, I_CB1, I_CDW, I_CDB, I_CLG, I_CLB, I_CW2, I_CB2, I_ANG, I_AWQKV, I_AQG, I_AKG, I_LQ1, I_LK1, I_LQ2, I_LK2, I_ASG, I_AWO, I_RB, I_FNG, I_FWG, I_FWU, I_FWD, I_PNG, I_PWG, I_PWP };

__device__ __forceinline__ int dst_row(int mode, int n) {
    if (mode == 0) return n;
    if (mode == 1) return 256 * (n >> 7) + (n & 127);
    if (mode == 2) return 256 * (n >> 7) + 128 + (n & 127);
    if (mode == 3) { const int part = n >> 10, c = n & 1023; return 256 * (c >> 7) + 128 * part + (c & 127); }
    if (n >= 2048) return n;
    { const int sec = n >> 10, c = n & 1023, j = c >> 6, i = c & 63; return sec * 1024 + 256 * (j >> 2) + 128 * (i >> 5) + 32 * (j & 3) + (i & 31); }
}
__device__ __forceinline__ void transpose_item(const float* W, int K, int N, bf16* WT, int mode, const float* gain, LAS float* scr, int item, int lane) {
    const int nblk = N / 32, kb = item / nblk, nb = item % nblk, k0 = 64 * kb, n0 = 32 * nb;
#pragma unroll
    for (int i = 0; i < 32; ++i) { const int kk = 2 * i + (lane >> 5); float w = W[(size_t)(k0 + kk) * N + n0 + (lane & 31)]; if (gain) w *= gain[k0 + kk]; scr[kk * 33 + (lane & 31)] = w; }
    LDS_WAIT(); asm volatile("" ::: "memory");
    const int c = lane & 7;
#pragma unroll
    for (int j = 0; j < 4; ++j) { const int n = (lane >> 3) + 8 * j; const LAS float* s = scr + (8 * c) * 33 + n;
        v4u o; o.x = pk2(s[0 * 33], s[1 * 33]); o.y = pk2(s[2 * 33], s[3 * 33]); o.z = pk2(s[4 * 33], s[5 * 33]); o.w = pk2(s[6 * 33], s[7 * 33]);
        const int p_ = dst_row(mode, n0 + n), pl_ = p_ & 127, x_ = pl_ & 31, R_ = (pl_ & ~31) + 16 * ((x_ >> 2) & 1) + 4 * (x_ >> 3) + (x_ & 3);
        *(GAS v4u*)((GAS unsigned char*)WT + ((size_t)(p_ >> 7) * (K / 64) + (k0 >> 6)) * 16384 + pg8::lds_byte(R_, 8 * c)) = o; }
    LDS_WAIT(); asm volatile("" ::: "memory");
}

__device__ __forceinline__ void p0_prologue(const Args& a, LAS unsigned char* lds, int vcu, int G, int wave, int lane) {
    unsigned char* ws = a.ws;
    LAS float* scr = (LAS float*)(lds + wave * 16384);
    const int gw = vcu * NWAVES + wave, NGW = G * NWAVES;
    constexpr int T_PW1 = 16 * 64, T_SQ = 16 * 32, T_QKV = 16 * 96, T_GU = 16 * 88, T_DN = 44 * 32, T_PP = 4 * 32;
    constexpr int NITEMS = T_PW1 + T_SQ + T_QKV + T_SQ + 4 * T_GU + 2 * T_DN + 2 * T_SQ + 2 * T_PP;
    for (int it = gw; it < NITEMS; it += NGW) {
        int r = it;
#define TR(cnt, W, K_, N_, DST, MODE, GAIN) if (r < (cnt)) { transpose_item((W), (K_), (N_), (bf16*)(ws + (DST)), (MODE), (GAIN), scr, r, lane); continue; } r -= (cnt);
        TR(T_PW1, a.in[I_CW1], D, 2 * D, WS_WPW1, 3, a.in[I_CNG])
        TR(T_SQ, a.in[I_CW2], D, D, WS_WPW2, 0, (const float*)nullptr)
        TR(T_QKV, a.in[I_AWQKV], D, 3 * D, WS_WQKV, 4, a.in[I_ANG])
        TR(T_SQ, a.in[I_AWO], D, D, WS_WO, 0, (const float*)nullptr)
        TR(T_GU, a.in[I_FWG], D, DFF, WS_WGU0, 1, a.in[I_FNG])
        TR(T_GU, a.in[I_FWU], D, DFF, WS_WGU0, 2, a.in[I_FNG])
        TR(T_GU, a.in[I_FWG] + (size_t)D * DFF, D, DFF, WS_WGU1, 1, a.in[I_FNG] + D)
        TR(T_GU, a.in[I_FWU] + (size_t)D * DFF, D, DFF, WS_WGU1, 2, a.in[I_FNG] + D)
        TR(T_DN, a.in[I_FWD], DFF, D, WS_WD0, 0, (const float*)nullptr)
        TR(T_DN, a.in[I_FWD] + (size_t)D * DFF, DFF, D, WS_WD1, 0, (const float*)nullptr)
        TR(T_SQ, a.in[I_PWG], D, D, WS_WPG0, 0, a.in[I_PNG])
        TR(T_SQ, a.in[I_PWG] + (size_t)D * D, D, D, WS_WPG1, 0, a.in[I_PNG] + D)
        TR(T_PP, a.in[I_PWP], PLE, D, WS_WPP0, 0, (const float*)nullptr)
        TR(T_PP, a.in[I_PWP] + (size_t)PLE * D, PLE, D, WS_WPP1, 0, (const float*)nullptr)
#undef TR
    }
    { const float* x = a.in[I_X]; bf16* hb = (bf16*)(ws + WS_HBA); float* ss = (float*)(ws + WS_SSA);
      for (int m0 = gw * 4; m0 < M; m0 += NGW * 4) {
          f32x4 v[4][4]; float s[4];
#pragma unroll
          for (int r = 0; r < 4; ++r) { const GAS f32x4* xr = (const GAS f32x4*)(x + (size_t)(m0 + r) * D) + lane;
#pragma unroll
              for (int j = 0; j < 4; ++j) v[r][j] = xr[64 * j]; }
#pragma unroll
          for (int r = 0; r < 4; ++r) { float t = 0.f;
#pragma unroll
              for (int j = 0; j < 4; ++j) t += (v[r][j].x * v[r][j].x + v[r][j].y * v[r][j].y) + (v[r][j].z * v[r][j].z + v[r][j].w * v[r][j].w);
              s[r] = wave_sum(t); }
#pragma unroll
          for (int r = 0; r < 4; ++r) {
#pragma unroll
              for (int j = 0; j < 4; ++j) *(GAS unsigned long long*)(hb + pg8::tiled_off(m0 + r, 4 * lane + 256 * j, D)) = (unsigned long long)pk2(v[r][j].x, v[r][j].y) | ((unsigned long long)pk2(v[r][j].z, v[r][j].w) << 32);
              if (lane < 16) ss[(size_t)(m0 + r) * 16 + lane] = lane == 0 ? s[r] : 0.f; } } }
    { const GAS f32x4* p = (const GAS f32x4*)a.in[I_P]; GAS unsigned long long* o = (GAS unsigned long long*)(ws + WS_PB); const size_t n4 = (size_t)2 * M * PLE / 4;
      const size_t stride = (size_t)NGW * 64;
      for (size_t i = (size_t)gw * 64 + lane; i < n4; i += 8 * stride) { f32x4 v[8];
#pragma unroll
          for (int k = 0; k < 8; ++k) v[k] = p[i + k * stride];
#pragma unroll
          for (int k = 0; k < 8; ++k) { const size_t e = (i + k * stride) * 4, lay = e / ((size_t)M * PLE), rem = e % ((size_t)M * PLE);
              *(GAS unsigned long long*)((bf16*)(ws + WS_PB) + lay * ((size_t)M * PLE) + pg8::tiled_off((int)(rem / PLE), (int)(rem % PLE), PLE)) = (unsigned long long)pk2(v[k].x, v[k].y) | ((unsigned long long)pk2(v[k].z, v[k].w) << 32); } } }
    if (gw == 0) { const float* rb = a.in[I_RB]; float* bt = (float*)(ws + WS_BT);
        for (int i = lane; i < 8 * 128; i += 64) { const int h = i >> 7, d = i & 127; bt[i] = (rb[T5_BUCKET[d] * 8 + h] - rb[31 * 8 + h]) * 1.4426950408889634f; } }
}

__device__ __forceinline__ void conv_phase(const Args& a, LAS unsigned char* lds, int vcu, int G, int tid, int wave, int lane) {
    const bf16* U = (const bf16*)(a.ws + WS_U); bf16* V2 = (bf16*)(a.ws + WS_V2);
    const float* dw = a.in[I_CDW]; const float* db = a.in[I_CDB]; const float* lg = a.in[I_CLG]; const float* lb = a.in[I_CLB];
    typedef float f32x2 __attribute__((ext_vector_type(2)));
    LAS f32x2* red = (LAS f32x2*)lds;
    LAS f32x2* stat = (LAS f32x2*)(lds + 4096);
    const int c0 = 2 * tid;
    f32x2 w[CW];
#pragma unroll
    for (int j = 0; j < CW; ++j) w[j] = *(const f32x2*)(dw + j * D + c0);
    const f32x2 bias = *(const f32x2*)(db + c0), g2 = *(const f32x2*)(lg + c0), b2 = *(const f32x2*)(lb + c0);
    for (int ch = vcu; ch < M / 32; ch += G) {
        const int t0 = ch * 32, tb = t0 & (SEQ - 1);
        unsigned u[62];
#pragma unroll
        for (int i = 0; i < 62; ++i) { const int dt = i - 30; u[i] = (tb + dt >= 0) ? *(const unsigned*)(U + (size_t)(t0 + dt) * D + c0) : 0u; }
        f32x2 o[32];
#pragma unroll
        for (int i = 0; i < 32; ++i) { f32x2 acc = bias;
#pragma unroll
            for (int j = 0; j < CW; ++j) { const unsigned uu = u[i + j]; f32x2 x; x.x = __uint_as_float(uu << 16); x.y = __uint_as_float(uu & 0xffff0000u); acc += w[j] * x; }
            o[i] = acc; }
        { float v[64];
#pragma unroll
            for (int i = 0; i < 32; ++i) { v[2 * i] = o[i].x + o[i].y; v[2 * i + 1] = o[i].x * o[i].x + o[i].y * o[i].y; }
#define RS_STEP(m_, n_) { const bool up_ = (lane & (m_)) != 0; _Pragma("unroll") for (int j = 0; j < (n_); ++j) { const float a_ = v[j], b_ = v[j + (n_)]; const float send_ = up_ ? a_ : b_, keep_ = up_ ? b_ : a_; v[j] = keep_ + __shfl_xor(send_, (m_)); } }
            RS_STEP(32, 32) RS_STEP(16, 16) RS_STEP(8, 8) RS_STEP(4, 4) RS_STEP(2, 2) RS_STEP(1, 1)
#undef RS_STEP
            ((LAS float*)red)[wave * 64 + lane] = v[0]; }
        __syncthreads();
        if (tid < 32) { float s = 0.f, q = 0.f;
#pragma unroll
            for (int wv = 0; wv < 8; ++wv) { const f32x2 r = red[wv * 32 + tid]; s += r.x; q += r.y; }
            const float mean = s * (1.0f / D), var = fmaxf(q * (1.0f / D) - mean * mean, 0.f);
            stat[tid] = (f32x2){mean, __builtin_amdgcn_rsqf(var + 1e-6f)}; }
        __syncthreads();
#pragma unroll
        for (int i = 0; i < 32; ++i) { const f32x2 st = stat[i]; f32x2 y = (o[i] - st.x) * st.y * g2 + b2;
            y.x = y.x * pg8::fast_sigmoid(y.x); y.y = y.y * pg8::fast_sigmoid(y.y);
            *(unsigned*)(V2 + pg8::tiled_off(t0 + i, c0, D)) = pk2(y.x, y.y); }
        __syncthreads();
    }
}

__device__ __forceinline__ void combine_local(const Args& a, int vcu, int wave, int lane) {
    constexpr float LINIT = 0.35550906759f;
    bf16* O0 = (bf16*)(a.ws + WS_HBA); const bf16* O1 = (const bf16*)(a.ws + WS_O1);
    const float d1 = wave_sum(a.in[I_LQ1][lane] * a.in[I_LK1][lane]), d2 = wave_sum(a.in[I_LQ2][lane] * a.in[I_LK2][lane]);
    const float lam = __expf(d1) - __expf(d2) + LINIT;
    float g[16];
#pragma unroll
    for (int e = 0; e < 16; ++e) g[e] = a.in[I_ASG][(lane & 7) * 16 + e] * (1.0f - LINIT);
    const int p = vcu >> 3, b = p >> 3, h = p & 7, s = vcu & 7;
#pragma unroll 1
    for (int k = 0; k < 4; ++k) { const int qb = (k == 0) ? s : (k == 1) ? 15 - s : (k == 2) ? 16 + s : 31 - s;
#pragma unroll 2
        for (int it = 0; it < 4; ++it) { const size_t off = pg8::tiled_off(b * SEQ + 256 * qb + 32 * wave + 8 * it + (lane >> 3), h * 128 + (lane & 7) * 16, D);
            const v4u* p0 = (const v4u*)(O0 + off); const v4u* p1 = (const v4u*)(O1 + off);
            const v4u a0 = p0[0], a1 = p0[1], b0 = p1[0], b1 = p1[1];
            const unsigned aw[8] = {a0.x, a0.y, a0.z, a0.w, a1.x, a1.y, a1.z, a1.w}, bw[8] = {b0.x, b0.y, b0.z, b0.w, b1.x, b1.y, b1.z, b1.w};
            float o[16]; float ssq = 0.f;
#pragma unroll
            for (int e = 0; e < 8; ++e) { o[2 * e] = __uint_as_float(aw[e] << 16) - lam * __uint_as_float(bw[e] << 16); o[2 * e + 1] = __uint_as_float(aw[e] & 0xffff0000u) - lam * __uint_as_float(bw[e] & 0xffff0000u);
                ssq += o[2 * e] * o[2 * e] + o[2 * e + 1] * o[2 * e + 1]; }
            ssq += __shfl_xor(ssq, 1); ssq += __shfl_xor(ssq, 2); ssq += __shfl_xor(ssq, 4);
            const float r = __builtin_amdgcn_rsqf(ssq * (1.0f / 128.0f) + 1e-6f);
            v4u w0, w1;
            w0.x = pk2(o[0] * r * g[0], o[1] * r * g[1]); w0.y = pk2(o[2] * r * g[2], o[3] * r * g[3]); w0.z = pk2(o[4] * r * g[4], o[5] * r * g[5]); w0.w = pk2(o[6] * r * g[6], o[7] * r * g[7]);
            w1.x = pk2(o[8] * r * g[8], o[9] * r * g[9]); w1.y = pk2(o[10] * r * g[10], o[11] * r * g[11]); w1.z = pk2(o[12] * r * g[12], o[13] * r * g[13]); w1.w = pk2(o[14] * r * g[14], o[15] * r * g[15]);
            v4u* q0 = (v4u*)(O0 + off); q0[0] = w0; q0[1] = w1; } }
}

#ifndef MK_PER_PHASE
#define MK_PER_PHASE 0
#endif
constexpr int N_PHASES = 15;
__global__ void __launch_bounds__(NWAVES * 64, 2) mega_fwd(Args args) {
    extern __shared__ __attribute__((aligned(16))) unsigned char lds_raw[];
    cg::grid_group grid = cg::this_grid();
    LAS unsigned char* lds = (LAS unsigned char*)lds_raw;
    const int tid = threadIdx.x, lane = tid & 63, wave = __builtin_amdgcn_readfirstlane(tid >> 6);
    const int G = gridDim.x, bx = blockIdx.x, vcu = (G % 8 == 0) ? (bx % 8) * (G / 8) + bx / 8 : bx;
    unsigned char* ws = args.ws;
    const int lo = args.ph_lo, hi = args.ph_hi;
    volatile LAS unsigned* MISC = (volatile LAS unsigned*)(lds + RING_BYTES + 64);
    if (tid < 2) MISC[tid] = 0u;
    __syncthreads();
    const XcdBarrier bar = xcd_barrier_post((unsigned*)(ws + WS_CTL), MISC);
    if (lo < 0) grid.sync();
#ifndef ONLY
#define ONLY -1
#endif
#define IN(k) (lo <= (k) && (k) < hi && (ONLY < 0 || ONLY == (k)))
#define SEAM(k) do { if (IN(k) && IN((k) + 1)) xcd_barrier(bar); } while (0)
    bf16* HBA = (bf16*)(ws + WS_HBA); bf16* HBB = (bf16*)(ws + WS_HBB); float* SSA = (float*)(ws + WS_SSA); float* SSB = (float*)(ws + WS_SSB);
    float* H = args.out;
    typedef pg8::StaticOrder SO;
#define RUN_GEMM_RM(EPI, A_, B_, N_, K_, E_) do { pg8::Gemm g_{(const bf16*)(A_), (const bf16*)(ws + (B_)), M, (N_), (K_)}; SO S_; S_.init(M, (N_), G, bx); \
        pg8::gemm_phase<EPI, SO, PG8_ALIGN, PG8_SP2, false>(lds, g_, S_, (E_)); } while (0)
#define RUN_GEMM(EPI, A_, B_, N_, K_, E_) do { pg8::Gemm g_{(const bf16*)(A_), (const bf16*)(ws + (B_)), M, (N_), (K_)}; SO S_; S_.init(M, (N_), G, bx); \
        pg8::gemm_phase<EPI, SO, PG8_ALIGN, PG8_SP2>(lds, g_, S_, (E_)); } while (0)

#ifndef NO_PRO
    if (IN(0)) { p0_prologue(args, lds, vcu, G, wave, lane); }
#endif
    SEAM(0);
    if (IN(1)) {
        pg8::EpiGated<0> E{(bf16*)(ws + WS_U), D, SSA, args.in[I_CB1], args.in[I_CB1] + D};
        RUN_GEMM(pg8::EpiGated<0>, HBA, WS_WPW1, 2 * D, D, E);
    }
    SEAM(1);
    #ifndef NO_CONV
    if (IN(2)) { __syncthreads(); conv_phase(args, lds, vcu, G, tid, wave, lane); }
#endif
    SEAM(2);
    if (IN(3)) {
        typedef pg8::EpiRes<0, true, false> EP; EP E{args.in[I_X], nullptr, nullptr, HBA, SSA, args.in[I_CB2], nullptr, nullptr};
        RUN_GEMM(EP, ws + WS_V2, WS_WPW2, D, D, E);
    }
    SEAM(3);
    if (IN(4)) {
        pg8::EpiGated<1> E{(bf16*)(ws + WS_F), DFF, SSA, nullptr, nullptr};
        RUN_GEMM(pg8::EpiGated<1>, HBA, WS_WGU0, 2 * DFF, D, E);
    }
    SEAM(4);
    if (IN(5)) {
        typedef pg8::EpiRes<0, false, false> EP; EP E{nullptr, HBA, nullptr, HBA, SSA, nullptr, nullptr, nullptr};
        RUN_GEMM(EP, ws + WS_F, WS_WD0, D, DFF, E);
        pg8::EpiPlain E2{(bf16*)(ws + WS_PP), D};
        RUN_GEMM(pg8::EpiPlain, ws + WS_PB, WS_WPP0, D, PLE, E2);
    }
    SEAM(5);
    if (IN(6)) {
        typedef pg8::EpiRes<1, false, false> EP; EP E{nullptr, HBA, nullptr, HBB, SSB, nullptr, SSA, (const bf16*)(ws + WS_PP)};
        RUN_GEMM(EP, HBA, WS_WPG0, D, D, E);
    }
    SEAM(6);
    if (IN(7)) {
        pg8::EpiQKV E{(bf16*)(ws + WS_Q), (bf16*)(ws + WS_K), (bf16*)(ws + WS_V), SSB, args.in[I_AQG], args.in[I_AKG], attn_body::C2};
        RUN_GEMM(pg8::EpiQKV, HBB, WS_WQKV, 3 * D, D, E);
    }
    SEAM(7);
    if (IN(8)) {
        __syncthreads();
        { const float* bt = (const float*)(ws + WS_BT) + ((vcu >> 3) & 7) * 128; LAS float* dst = (LAS float*)(lds + attn_body::LDS_BIAS);
          for (int i = tid; i < 1024; i += NWAVES * 64) { const int d = i - 256; dst[i] = d < 0 ? -__builtin_inff() : bt[d > 127 ? 127 : d]; } }
        asm volatile("s_waitcnt vmcnt(0) lgkmcnt(0)" ::: "memory"); __syncthreads();
        const attn_body::AttnTensors AT{(const attn_body::bf16*)(ws + WS_Q), (const attn_body::bf16*)(ws + WS_K), (const attn_body::bf16*)(ws + WS_V), (attn_body::bf16*)(ws + WS_HBA), (attn_body::bf16*)(ws + WS_O1)};
        const attn_body::StaticOrder S(G, bx);
#ifndef NO_ATTN
        attn_body::attn_phase<attn_body::StaticOrder>((char*)lds_raw, AT, S);
#endif
        asm volatile("s_waitcnt vmcnt(0)" ::: "memory"); __builtin_amdgcn_fence(__ATOMIC_ACQ_REL, "workgroup"); __syncthreads();
        combine_local(args, vcu, wave, lane);
    }
    SEAM(8);
    if (IN(10)) {
        typedef pg8::EpiRes<0, false, false> EP; EP E{nullptr, HBB, nullptr, HBB, SSB, nullptr, nullptr, nullptr};
        RUN_GEMM(EP, HBA, WS_WO, D, D, E);
    }
    SEAM(10);
    if (IN(11)) {
        pg8::EpiGated<1> E{(bf16*)(ws + WS_F), DFF, SSB, nullptr, nullptr};
        RUN_GEMM(pg8::EpiGated<1>, HBB, WS_WGU1, 2 * DFF, D, E);
    }
    SEAM(11);
    if (IN(12)) {
        typedef pg8::EpiRes<0, false, false> EP; EP E{nullptr, HBB, nullptr, HBB, SSB, nullptr, nullptr, nullptr};
        RUN_GEMM(EP, ws + WS_F, WS_WD1, D, DFF, E);
        pg8::EpiPlain E2{(bf16*)(ws + WS_PP), D};
        RUN_GEMM(pg8::EpiPlain, ws + WS_PB + (size_t)M * PLE * 2, WS_WPP1, D, PLE, E2);
    }
    SEAM(12);
    if (IN(13)) {
        typedef pg8::EpiRes<1, false, true> EP; EP E{nullptr, HBB, H, nullptr, nullptr, nullptr, SSB, (const bf16*)(ws + WS_PP)};
        RUN_GEMM(EP, HBB, WS_WPG1, D, D, E);
    }
#undef IN
#undef SEAM
#undef RUN_GEMM
}

extern "C" void kernel_launch(void* const* d_in, const int* in_sizes, int n_in, void* d_out, int out_size, void* d_ws, size_t ws_size, hipStream_t stream) {
    static int grid = 0;
    if (grid == 0) {
        if (n_in != 29 || in_sizes[0] != M * D || out_size != M * D || ws_size < WS_END) { fprintf(stderr, "kernel_launch: unexpected shapes / workspace (n_in %d, ws %zu)\n", n_in, ws_size); grid = -1; return; }
        int dev = 0, cus = 0, per_cu = 0;
        if (hipGetDevice(&dev) != hipSuccess || hipDeviceGetAttribute(&cus, hipDeviceAttributeMultiprocessorCount, dev) != hipSuccess) { grid = -1; return; }
        if (hipFuncSetAttribute((const void*)mega_fwd, hipFuncAttributeMaxDynamicSharedMemorySize, LDS_TOTAL) != hipSuccess) { fprintf(stderr, "hipFuncSetAttribute failed\n"); grid = -1; return; }
        if (hipOccupancyMaxActiveBlocksPerMultiprocessor(&per_cu, (const void*)mega_fwd, NWAVES * 64, LDS_TOTAL) != hipSuccess || per_cu < 1) { fprintf(stderr, "occupancy query: %d\n", per_cu); per_cu = 1; }
        (void)hipGetLastError();
        grid = cus * per_cu;
        fprintf(stderr, "kernel_launch: grid %d (cus %d x %d)\n", grid, cus, per_cu);
    }
    if (grid < 0) return;
    if (hipMemsetAsync((char*)d_ws + WS_CTL, 0, 65536, stream) != hipSuccess) { fprintf(stderr, "memset failed\n"); return; }
    Args a{};
    for (int i = 0; i < 29; ++i) a.in[i] = (const float*)d_in[i];
    a.out = (float*)d_out; a.ws = (unsigned char*)d_ws;
    void* kargs[] = {&a};
#if MK_PER_PHASE
    for (int ph = 0; ph < N_PHASES - 1; ++ph) { a.ph_lo = ph; a.ph_hi = ph + 1;
        hipError_t e = hipLaunchCooperativeKernel((const void*)mega_fwd, dim3(grid), dim3(NWAVES * 64), kargs, LDS_TOTAL, stream);
        if (e != hipSuccess) { fprintf(stderr, "launch %d failed: %s\n", ph, hipGetErrorString(e)); break; } }
#else
    a.ph_lo = 0; a.ph_hi = N_PHASES;
    hipError_t e = hipLaunchCooperativeKernel((const void*)mega_fwd, dim3(grid), dim3(NWAVES * 64), kargs, LDS_TOTAL, stream);
    if (e != hipSuccess) fprintf(stderr, "cooperative launch failed: %s (grid %d)\n", hipGetErrorString(e), grid);
#endif
}
```
